# Optimizing an MI355X kernel written in HIP

```python
import math
import jax
import jax.numpy as jnp
from jax import lax
import numpy as np


D_MODEL = 1024
BATCH = 8
SEQ = 2048
DEPTH = 2

N_EVEN = (DEPTH + 1) // 2
N_ODD = DEPTH // 2
MIX_WIDTH = D_MODEL
Q_BLOCK = 128
RMS_EPS = 1e-6
F32 = jnp.float32

MLA_HEADS = 8
MLA_NOPE = 64
MLA_ROPE = 32
MLA_V = 64
MLA_Q_LORA = 384
MLA_KV_LORA = 256
ROPE_BASE = 10000.0

S5_WIDTH = MIX_WIDTH - MLA_HEADS * MLA_V
S5_GROUP = 16
S5_GROUPS = S5_WIDTH // S5_GROUP
S5_STATE = 64
S5_DT_MIN = 0.001
S5_DT_MAX = 0.1

SB_HEADS = 8
SB_HEAD_DIM = 64
SB_WIDTH = SB_HEADS * SB_HEAD_DIM

LRU_WIDTH = MIX_WIDTH - SB_WIDTH
LRU_BLOCKS = 8
LRU_BLOCK_DIM = LRU_WIDTH // LRU_BLOCKS
LRU_C = 8.0
CONV_WIDTH = 4

FFN_HIDDEN = -(-8 * D_MODEL // (3 * 256)) * 256

IN_EVEN = MLA_Q_LORA + MLA_KV_LORA + MLA_ROPE + S5_WIDTH
IN_ODD = 3 * SB_WIDTH + 2 * LRU_WIDTH

kernel_name = 'hybrid_mla_s5_stickbreak_rglru_block'


def _rmsnorm(x, g):
    x32 = x.astype(F32)
    y = x32 * lax.rsqrt(jnp.mean(x32 * x32, axis=-1, keepdims=True) + RMS_EPS)
    return (y * g.astype(F32)).astype(x.dtype)


def _rope(x, pos):
    half = x.shape[-1] // 2
    inv = ROPE_BASE ** (-jnp.arange(half, dtype=F32) / half)
    ang = pos.astype(F32)[..., None, None] * inv
    cos, sin = jnp.cos(ang), jnp.sin(ang)
    x1, x2 = x[..., :half].astype(F32), x[..., half:].astype(F32)
    return jnp.concatenate([x1 * cos - x2 * sin, x2 * cos + x1 * sin], axis=-1).astype(x.dtype)


def _linear_scan(a, b):
    def op(left, right):
        return (left[0] * right[0], right[0] * left[1] + right[1])
    return lax.associative_scan(op, (a, b), axis=1)[1]


def _split_query_blocks(q):
    b, h, l, d = q.shape
    return q.reshape(b, h, l // Q_BLOCK, Q_BLOCK, d).transpose(2, 0, 1, 3, 4)


def _merge_query_blocks(o):
    nb, b, h, qb, d = o.shape
    return o.transpose(1, 2, 0, 3, 4).reshape(b, h, nb * qb, d)


def _causal_softmax_attn(q, k, v):
    seq = q.shape[2]
    scale = q.shape[-1] ** -0.5
    kpos = jnp.arange(seq)

    def block(args):
        qi, i = args
        s = jnp.einsum('bhqd,bhkd->bhqk', qi, k).astype(F32) * scale
        qpos = i * Q_BLOCK + jnp.arange(Q_BLOCK)
        s = jnp.where(kpos[None, :] <= qpos[:, None], s, -1e30)
        p = jax.nn.softmax(s, axis=-1)
        return jnp.einsum('bhqk,bhkd->bhqd', p.astype(v.dtype), v)

    o = lax.map(block, (_split_query_blocks(q), jnp.arange(seq // Q_BLOCK)))
    return _merge_query_blocks(o)


def _stick_breaking_attn(q, k, v):
    seq = q.shape[2]
    scale = q.shape[-1] ** -0.5
    kpos = jnp.arange(seq)

    def block(args):
        qi, i = args
        z = jnp.einsum('bhqd,bhkd->bhqk', qi, k).astype(F32) * scale
        qpos = i * Q_BLOCK + jnp.arange(Q_BLOCK)
        mask = kpos[None, :] < qpos[:, None]
        log_beta = jax.nn.log_sigmoid(z)
        log_1m_beta = jnp.where(mask, jax.nn.log_sigmoid(-z), 0.0)
        suffix = lax.cumsum(log_1m_beta, axis=3, reverse=True) - log_1m_beta
        w = jnp.where(mask, jnp.exp(log_beta + suffix), 0.0)
        return jnp.einsum('bhqk,bhkd->bhqd', w.astype(v.dtype), v)

    o = lax.map(block, (_split_query_blocks(q), jnp.arange(seq // Q_BLOCK)))
    return _merge_query_blocks(o)


def _s5(u, lam_re, lam_im, log_dt, b_re, b_im, c_re, c_im, d_skip, w_glu, b_glu):
    bsz, seq, _ = u.shape
    ug = u.astype(F32).reshape(bsz, seq, S5_GROUPS, S5_GROUP)
    lam = lax.complex(jnp.minimum(lam_re.astype(F32), -1e-4), lam_im.astype(F32))
    dt = jnp.exp(log_dt.astype(F32))[:, None]
    lam_bar = jnp.exp(lam * dt)
    b_mat = lax.complex(b_re.astype(F32), b_im.astype(F32))
    b_bar = ((lam_bar - 1.0) / lam)[..., None] * b_mat
    bu = jnp.einsum('blgc,gpc->blgp', ug.astype(jnp.complex64), b_bar)
    states = _linear_scan(jnp.broadcast_to(lam_bar, bu.shape), bu)
    c_mat = lax.complex(c_re.astype(F32), c_im.astype(F32))
    y = jnp.real(jnp.einsum('blgp,gcp->blgc', states, c_mat)) + d_skip.astype(F32) * ug
    y = jax.nn.gelu(y.reshape(bsz, seq, S5_WIDTH))
    y = y * jax.nn.sigmoid(y @ w_glu.astype(F32) + b_glu.astype(F32))
    return y.astype(u.dtype)


def _even_mixer(u, pos, w_in, q_norm_g, kv_norm_g, w_q_up, w_kv_up,
                lam_re, lam_im, log_dt, b_re, b_im, c_re, c_im, d_skip, w_glu, b_glu):
    bsz, seq, _ = u.shape
    proj = u @ w_in
    q_lat, kv_lat, k_rope, s5_u = jnp.split(
        proj, [MLA_Q_LORA, MLA_Q_LORA + MLA_KV_LORA, MLA_Q_LORA + MLA_KV_LORA + MLA_ROPE], axis=-1)
    q = (_rmsnorm(q_lat, q_norm_g) @ w_q_up).reshape(bsz, seq, MLA_HEADS, MLA_NOPE + MLA_ROPE)
    q = jnp.concatenate([q[..., :MLA_NOPE], _rope(q[..., MLA_NOPE:], pos)], axis=-1)
    kv = (_rmsnorm(kv_lat, kv_norm_g) @ w_kv_up).reshape(bsz, seq, MLA_HEADS, MLA_NOPE + MLA_V)
    k_r = _rope(k_rope[:, :, None, :], pos)
    k = jnp.concatenate([kv[..., :MLA_NOPE], jnp.broadcast_to(k_r, (bsz, seq, MLA_HEADS, MLA_ROPE))], axis=-1)
    v = kv[..., MLA_NOPE:]
    attn = _causal_softmax_attn(q.transpose(0, 2, 1, 3), k.transpose(0, 2, 1, 3), v.transpose(0, 2, 1, 3))
    attn = attn.transpose(0, 2, 1, 3).reshape(bsz, seq, MLA_HEADS * MLA_V)
    ssm = _s5(s5_u, lam_re, lam_im, log_dt, b_re, b_im, c_re, c_im, d_skip, w_glu, b_glu)
    return jnp.concatenate([attn, ssm], axis=-1)


def _odd_mixer(u, w_in, conv_w, conv_b, w_a, b_a, w_x, b_x, lam):
    bsz, seq, _ = u.shape
    proj = u @ w_in
    q, k, v, xr, yg = jnp.split(
        proj, [SB_WIDTH, 2 * SB_WIDTH, 3 * SB_WIDTH, 3 * SB_WIDTH + LRU_WIDTH], axis=-1)

    def heads(t):
        return t.reshape(bsz, seq, SB_HEADS, SB_HEAD_DIM).transpose(0, 2, 1, 3)

    sb = _stick_breaking_attn(heads(q), heads(k), heads(v))
    sb = sb.transpose(0, 2, 1, 3).reshape(bsz, seq, SB_WIDTH)
    xc = lax.conv_general_dilated(
        xr, conv_w[:, None, :].astype(xr.dtype), window_strides=(1,), padding=[(CONV_WIDTH - 1, 0)],
        dimension_numbers=('NWC', 'WIO', 'NWC'), feature_group_count=LRU_WIDTH) + conv_b
    xg = xc.reshape(bsz, seq, LRU_BLOCKS, LRU_BLOCK_DIM)
    r = jax.nn.sigmoid(jnp.einsum('blnc,ncd->blnd', xg, w_a).reshape(bsz, seq, LRU_WIDTH) + b_a)
    i = jax.nn.sigmoid(jnp.einsum('blnc,ncd->blnd', xg, w_x).reshape(bsz, seq, LRU_WIDTH) + b_x)
    log_a = LRU_C * r.astype(F32) * jax.nn.log_sigmoid(lam.astype(F32))
    a = jnp.exp(log_a)
    inp = jnp.sqrt(-jnp.expm1(2.0 * log_a)) * (i * xc).astype(F32)
    h = _linear_scan(a, inp)
    rec = h.astype(u.dtype) * jax.nn.gelu(yg)
    return jnp.concatenate([sb, rec], axis=-1)


def _swiglu(u, w_gate, w_up, w_down):
    return (jax.nn.silu(u @ w_gate) * (u @ w_up)) @ w_down


def setup_inputs(seed: int = 0) -> dict:
    key = jax.random.key(seed)
    ks = iter(jax.random.split(key, 64))

    def nrm(shape, scale):
        return scale * jax.random.normal(next(ks), shape, F32)

    x = nrm((BATCH, SEQ, D_MODEL), 1.0)
    c = nrm((BATCH, D_MODEL), 1.0)
    positions = (jax.random.randint(next(ks), (BATCH, 1), 0, 1024) + jnp.arange(SEQ)[None, :]).astype(jnp.int32)
    mod_w = nrm((DEPTH, D_MODEL, 6 * D_MODEL), 0.5 * D_MODEL ** -0.5)
    mod_b = nrm((DEPTH, 6 * D_MODEL), 0.01)
    norm_g = 1.0 + nrm((DEPTH, 4, D_MODEL), 0.01)
    w_out = nrm((DEPTH, MIX_WIDTH, D_MODEL), MIX_WIDTH ** -0.5)
    ffn_w_gate = nrm((DEPTH, D_MODEL, FFN_HIDDEN), D_MODEL ** -0.5)
    ffn_w_up = nrm((DEPTH, D_MODEL, FFN_HIDDEN), D_MODEL ** -0.5)
    ffn_w_down = nrm((DEPTH, FFN_HIDDEN, D_MODEL), FFN_HIDDEN ** -0.5)
    even_w_in = nrm((N_EVEN, D_MODEL, IN_EVEN), D_MODEL ** -0.5)
    mla_q_norm_g = 1.0 + nrm((N_EVEN, MLA_Q_LORA), 0.01)
    mla_kv_norm_g = 1.0 + nrm((N_EVEN, MLA_KV_LORA), 0.01)
    mla_w_q_up = nrm((N_EVEN, MLA_Q_LORA, MLA_HEADS * (MLA_NOPE + MLA_ROPE)), MLA_Q_LORA ** -0.5)
    mla_w_kv_up = nrm((N_EVEN, MLA_KV_LORA, MLA_HEADS * (MLA_NOPE + MLA_V)), MLA_KV_LORA ** -0.5)
    s5_lam_re = -0.5 + nrm((N_EVEN, S5_GROUPS, S5_STATE), 0.01)
    s5_lam_im = math.pi * jnp.arange(S5_STATE, dtype=F32) + nrm((N_EVEN, S5_GROUPS, S5_STATE), 0.01)
    s5_log_dt = jax.random.uniform(next(ks), (N_EVEN, S5_GROUPS), F32, math.log(S5_DT_MIN), math.log(S5_DT_MAX))
    s5_b_re = nrm((N_EVEN, S5_GROUPS, S5_STATE, S5_GROUP), (2 * S5_GROUP) ** -0.5)
    s5_b_im = nrm((N_EVEN, S5_GROUPS, S5_STATE, S5_GROUP), (2 * S5_GROUP) ** -0.5)
    s5_c_re = nrm((N_EVEN, S5_GROUPS, S5_GROUP, S5_STATE), S5_STATE ** -0.5)
    s5_c_im = nrm((N_EVEN, S5_GROUPS, S5_GROUP, S5_STATE), S5_STATE ** -0.5)
    s5_d = nrm((N_EVEN, S5_GROUPS, S5_GROUP), 1.0)
    s5_w_glu = nrm((N_EVEN, S5_WIDTH, S5_WIDTH), S5_WIDTH ** -0.5)
    s5_b_glu = nrm((N_EVEN, S5_WIDTH), 0.01)
    odd_w_in = nrm((N_ODD, D_MODEL, IN_ODD), D_MODEL ** -0.5)
    lru_conv_w = nrm((N_ODD, CONV_WIDTH, LRU_WIDTH), CONV_WIDTH ** -0.5)
    lru_conv_b = nrm((N_ODD, LRU_WIDTH), 0.01)
    lru_w_a = nrm((N_ODD, LRU_BLOCKS, LRU_BLOCK_DIM, LRU_BLOCK_DIM), LRU_BLOCK_DIM ** -0.5)
    lru_b_a = nrm((N_ODD, LRU_WIDTH), 0.01)
    lru_w_x = nrm((N_ODD, LRU_BLOCKS, LRU_BLOCK_DIM, LRU_BLOCK_DIM), LRU_BLOCK_DIM ** -0.5)
    lru_b_x = nrm((N_ODD, LRU_WIDTH), 0.01)
    a_c = jax.random.uniform(next(ks), (N_ODD, LRU_WIDTH), F32, 0.9, 0.999)
    a0 = a_c ** (1.0 / LRU_C)
    lru_lambda = jnp.log(a0) - jnp.log1p(-a0)
    return {
        'x': x, 'c': c, 'positions': positions,
        'mod_w': mod_w, 'mod_b': mod_b, 'norm_g': norm_g, 'w_out': w_out,
        'ffn_w_gate': ffn_w_gate, 'ffn_w_up': ffn_w_up, 'ffn_w_down': ffn_w_down,
        'even_w_in': even_w_in, 'mla_q_norm_g': mla_q_norm_g, 'mla_kv_norm_g': mla_kv_norm_g,
        'mla_w_q_up': mla_w_q_up, 'mla_w_kv_up': mla_w_kv_up,
        's5_lam_re': s5_lam_re, 's5_lam_im': s5_lam_im, 's5_log_dt': s5_log_dt,
        's5_b_re': s5_b_re, 's5_b_im': s5_b_im, 's5_c_re': s5_c_re, 's5_c_im': s5_c_im,
        's5_d': s5_d, 's5_w_glu': s5_w_glu, 's5_b_glu': s5_b_glu,
        'odd_w_in': odd_w_in, 'lru_conv_w': lru_conv_w, 'lru_conv_b': lru_conv_b,
        'lru_w_a': lru_w_a, 'lru_b_a': lru_b_a, 'lru_w_x': lru_w_x, 'lru_b_x': lru_b_x,
        'lru_lambda': lru_lambda,
    }


def reference(x, c, positions, mod_w, mod_b, norm_g, w_out, ffn_w_gate, ffn_w_up, ffn_w_down,
              even_w_in, mla_q_norm_g, mla_kv_norm_g, mla_w_q_up, mla_w_kv_up,
              s5_lam_re, s5_lam_im, s5_log_dt, s5_b_re, s5_b_im, s5_c_re, s5_c_im,
              s5_d, s5_w_glu, s5_b_glu,
              odd_w_in, lru_conv_w, lru_conv_b, lru_w_a, lru_b_a, lru_w_x, lru_b_x, lru_lambda):
    h = x
    c_act = jax.nn.silu(c)
    for layer in range(DEPTH):
        mod = (c_act @ mod_w[layer] + mod_b[layer])[:, None, :]
        sh_mix, sc_mix, g_mix, sh_ffn, sc_ffn, g_ffn = jnp.split(mod, 6, axis=-1)
        u = _rmsnorm(h, norm_g[layer, 0]) * (1.0 + sc_mix) + sh_mix
        j = layer // 2
        if layer % 2 == 0:
            m = _even_mixer(u, positions, even_w_in[j], mla_q_norm_g[j], mla_kv_norm_g[j],
                            mla_w_q_up[j], mla_w_kv_up[j], s5_lam_re[j], s5_lam_im[j], s5_log_dt[j],
                            s5_b_re[j], s5_b_im[j], s5_c_re[j], s5_c_im[j], s5_d[j],
                            s5_w_glu[j], s5_b_glu[j])
        else:
            m = _odd_mixer(u, odd_w_in[j], lru_conv_w[j], lru_conv_b[j], lru_w_a[j], lru_b_a[j],
                           lru_w_x[j], lru_b_x[j], lru_lambda[j])
        h = h + g_mix * _rmsnorm(m @ w_out[layer], norm_g[layer, 1])
        u = _rmsnorm(h, norm_g[layer, 2]) * (1.0 + sc_ffn) + sh_ffn
        f = _swiglu(u, ffn_w_gate[layer], ffn_w_up[layer], ffn_w_down[layer])
        h = h + g_ffn * _rmsnorm(f, norm_g[layer, 3])
    return h
```

```cpp
#include <hip/hip_runtime.h>
#include <cstdio>
#include <cstdint>

#ifndef MK_SINGLE
#define MK_SINGLE 0
#endif

#define LAS __attribute__((address_space(3)))
#define GAS __attribute__((address_space(1)))
typedef unsigned short bf16_t;
typedef short bf16x8 __attribute__((ext_vector_type(8)));
typedef short s16x4 __attribute__((ext_vector_type(4)));
typedef float f32x2 __attribute__((ext_vector_type(2)));
typedef float f32x4 __attribute__((ext_vector_type(4)));
typedef float f32x16 __attribute__((ext_vector_type(16)));
typedef unsigned u32x2 __attribute__((ext_vector_type(2)));
typedef unsigned u32x4 __attribute__((ext_vector_type(4)));
typedef __bf16 bf16x2_t __attribute__((ext_vector_type(2)));

constexpr int D = 1024, NB = 8, SEQ = 2048, M = NB * SEQ, FFH = 2816;
constexpr int IN0 = 1184, IN0P = 1280, IN1 = 2560;
constexpr float RMS_EPS = 1e-6f;
constexpr int NWAVES = 8, NTHR = 512;

constexpr size_t MiB = 1u << 20;
constexpr size_t WS_CTL = 0, CTL_ZERO_BYTES = 1 * MiB;
constexpr size_t WS_MODP = 1 * MiB;
constexpr size_t WS_MOD = 4 * MiB;
constexpr size_t WS_RS = 4 * MiB + 512 * 1024;
constexpr size_t WS_W = 6 * MiB;
constexpr size_t W_IN0 = WS_W;
constexpr size_t W_QUP = W_IN0 + (size_t)IN0P * D * 2;
constexpr size_t W_KVUP = W_QUP + (size_t)768 * 384 * 2;
constexpr size_t W_GLU = W_KVUP + (size_t)1024 * 256 * 2;
constexpr size_t W_OUT0 = W_GLU + (size_t)512 * 512 * 2;
constexpr size_t W_GU0 = W_OUT0 + (size_t)D * D * 2;
constexpr size_t W_DN0 = W_GU0 + (size_t)2 * FFH * D * 2;
constexpr size_t W_IN1 = W_DN0 + (size_t)D * FFH * 2;
constexpr size_t W_OUT1 = W_IN1 + (size_t)IN1 * D * 2;
constexpr size_t W_GU1 = W_OUT1 + (size_t)D * D * 2;
constexpr size_t W_DN1 = W_GU1 + (size_t)2 * FFH * D * 2;
constexpr size_t W_END = W_DN1 + (size_t)D * FFH * 2;
static_assert(W_END <= 54 * MiB, "weights region");
constexpr size_t WS_XN = 54 * MiB;
constexpr size_t WS_MIX = 86 * MiB;
constexpr size_t WS_PROJ0 = 118 * MiB;
constexpr size_t WS_Q = 158 * MiB;
constexpr size_t WS_K96 = 182 * MiB;
constexpr size_t WS_V = 206 * MiB;
constexpr size_t WS_Y = 222 * MiB;
constexpr size_t WS_PROJ1 = 118 * MiB;
constexpr size_t WS_FOUT = 118 * MiB;
constexpr size_t WS_FDN = 86 * MiB;
constexpr size_t WS_HID = 168 * MiB;
constexpr size_t WS_END = 256 * MiB;

constexpr int RING_BYTES = 131072;
constexpr int LDSCTL_OFF = RING_BYTES, MISC_OFF = LDSCTL_OFF + 320;
constexpr int LDS_BYTES = 147456;

#define LDS_WAIT() asm volatile("s_waitcnt lgkmcnt(0)" ::: "memory")
#define VM_WAIT() asm volatile("s_waitcnt vmcnt(0)" ::: "memory")
__device__ __forceinline__ unsigned cvtpk(float lo, float hi) { f32x2 v = {lo, hi}; bf16x2_t b = __builtin_convertvector(v, bf16x2_t); return __builtin_bit_cast(unsigned, b); }
__device__ __forceinline__ float bf2f(unsigned short b) { return __uint_as_float((unsigned)b << 16); }
__device__ __forceinline__ float bflo(unsigned w) { return __uint_as_float(w << 16); }
__device__ __forceinline__ float bfhi(unsigned w) { return __uint_as_float(w & 0xffff0000u); }
__device__ __forceinline__ float wave_sum(float v) {
#pragma unroll
    for (int o = 1; o < 64; o <<= 1) v += __shfl_xor(v, o);
    return v;
}
__device__ __forceinline__ float ex2(float x) { return __builtin_amdgcn_exp2f(x); }
__device__ __forceinline__ float lg2(float x) { return __builtin_amdgcn_logf(x); }
__device__ __forceinline__ float rcp(float x) { return __builtin_amdgcn_rcpf(x); }
constexpr float LOG2E = 1.4426950408889634f, LN2 = 0.6931471805599453f;
__device__ __forceinline__ float sigmoidf_(float x) { return rcp(1.0f + ex2(-x * LOG2E)); }
__device__ __forceinline__ float gelu_tanh(float x) { const float u = 0.7978845608028654f * (x + 0.044715f * x * x * x); return x * rcp(1.0f + ex2(-2.0f * LOG2E * u)); }
__device__ __forceinline__ int crow(int r, int hi) { return (r & 3) + 8 * (r >> 2) + 4 * hi; }
__device__ __forceinline__ float bsel(unsigned mask, float a, float b) { return __uint_as_float((__float_as_uint(a) & mask) | (__float_as_uint(b) & ~mask)); }

namespace pg8 {
constexpr int BM = 256, BK = 64, HALF = 128, HTB = HALF * BK * 2, STAGE_BYTES = 8 * HTB, NXCD = 8, WGM = 8;
__host__ __device__ __forceinline__ int lds_byte(int r, int c) { const int st = (r >> 4) * 2 + (c >> 5), rr = r & 15, cc = c & 31, ob = rr * 64 + cc * 2; return st * 1024 + (ob ^ (((ob >> 9) & 1) << 5)); }
__host__ __device__ __forceinline__ void stage_rc(int b, int& R, int& C) { const int st = b / 1024, sb = b % 1024, swz = sb ^ (((sb >> 9) & 1) << 5); R = (st >> 1) * 16 + swz / 64; C = (st & 1) * 32 + (swz % 64) / 2; }
__host__ __device__ __forceinline__ int perm32(int rho) { const int n = rho >> 4, i = rho & 15; return 8 * (i >> 2) + 4 * n + (i & 3); }
struct Unit { int pm, pn; };
struct Gemm { const bf16_t* A; const bf16_t* Bt; int M, N, K, lda; };
struct StaticOrder {
    int nM, nN, nwg, G, c;
    __device__ void init(int M_, int N_, int G_, int c_) { nM = M_ / BM; nN = N_ / BM; nwg = nM * nN; G = G_; c = c_; }
    __device__ bool next(int i, Unit& u) const {
        const long L = (long)i * G + c; if (L >= nwg) return false;
        int wgid = (int)L; { const int q = nwg / NXCD, r = nwg % NXCD, xcd = wgid % NXCD, off = wgid / NXCD; wgid = (xcd < r ? xcd * (q + 1) : r * (q + 1) + (xcd - r) * q) + off; }
        const int nig = WGM * nN, gid = wgid / nig, fm = gid * WGM, gsz = (nM - fm) < WGM ? (nM - fm) : WGM;
        u.pm = fm + ((wgid % nig) % gsz); u.pn = (wgid % nig) / gsz; return true;
    }
};

enum { EM_BF16 = 0, EM_KV = 1, EM_GLU = 2, EM_F32 = 3, EM_SWIGLU = 4 };
struct EpiP {
    int mode, perm;
    void* O; int ldc; void* O2;
    const float* rs;
    const float* bias;
    const bf16_t* Yin;
};
__device__ __forceinline__ void epi_run(const EpiP& E, const f32x4 (&acc)[2][2][4][2], const Unit& u, int wr, int wc, int fr, int fq) {
    const int row0 = u.pm * BM + wr * 64 + fr;
    if (E.mode == EM_F32) {
        const int col0 = u.pn * BM + wc * 32 + 4 * fq; float* C = (float*)E.O;
#pragma unroll
        for (int ai = 0; ai < 2; ++ai)
#pragma unroll
            for (int m = 0; m < 4; ++m) { float* rowp = C + (size_t)(row0 + ai * HALF + m * 16) * E.ldc + col0;
#pragma unroll
                for (int bj = 0; bj < 2; ++bj)
#pragma unroll
                    for (int n = 0; n < 2; ++n) *(f32x4*)(rowp + bj * HALF + n * 16) = acc[ai][bj][m][n]; }
    } else if (E.mode == EM_SWIGLU) {
        const int col0 = u.pn * HALF + wc * 32 + 8 * fq; bf16_t* O = (bf16_t*)E.O;
#pragma unroll
        for (int ai = 0; ai < 2; ++ai)
#pragma unroll
            for (int m = 0; m < 4; ++m) { bf16_t* rowp = O + (size_t)(row0 + ai * HALF + m * 16) * E.ldc + col0;
                float h[8];
#pragma unroll
                for (int n = 0; n < 2; ++n)
#pragma unroll
                    for (int i = 0; i < 4; ++i) { const float g = acc[ai][0][m][n][i], up = acc[ai][1][m][n][i]; h[4 * n + i] = g * sigmoidf_(g) * up; }
                u32x4 w; w.x = cvtpk(h[0], h[1]); w.y = cvtpk(h[2], h[3]); w.z = cvtpk(h[4], h[5]); w.w = cvtpk(h[6], h[7]);
                *(u32x4*)rowp = w; }
    } else {
#pragma unroll
        for (int ai = 0; ai < 2; ++ai)
#pragma unroll
            for (int m = 0; m < 4; ++m) { const int row = row0 + ai * HALF + m * 16; const float s = E.rs ? E.rs[row] : 1.0f;
#pragma unroll
                for (int bj = 0; bj < 2; ++bj) { const int col = u.pn * BM + bj * HALF + wc * 32 + 8 * fq;
                    f32x4 v0 = acc[ai][bj][m][0] * s, v1 = acc[ai][bj][m][1] * s;
                    bf16_t* dst;
                    if (E.mode == EM_BF16) dst = (bf16_t*)E.O + (size_t)row * E.ldc + col;
                    else if (E.mode == EM_KV) { const int head = col >> 7, w_ = col & 127;
                        dst = (w_ < 64) ? (bf16_t*)E.O + (size_t)row * 768 + head * 96 + w_ : (bf16_t*)E.O2 + (size_t)row * 512 + head * 64 + (w_ - 64); }
                    else {
                        const u32x4 yv = *(const u32x4*)(E.Yin + (size_t)row * 512 + col); const f32x4 b0 = *(const f32x4*)(E.bias + col), b1 = *(const f32x4*)(E.bias + col + 4);
                        v0[0] = bflo(yv.x) * sigmoidf_(v0[0] + b0[0]); v0[1] = bfhi(yv.x) * sigmoidf_(v0[1] + b0[1]); v0[2] = bflo(yv.y) * sigmoidf_(v0[2] + b0[2]); v0[3] = bfhi(yv.y) * sigmoidf_(v0[3] + b0[3]);
                        v1[0] = bflo(yv.z) * sigmoidf_(v1[0] + b1[0]); v1[1] = bfhi(yv.z) * sigmoidf_(v1[1] + b1[1]); v1[2] = bflo(yv.w) * sigmoidf_(v1[2] + b1[2]); v1[3] = bfhi(yv.w) * sigmoidf_(v1[3] + b1[3]);
                        dst = (bf16_t*)E.O + (size_t)row * E.ldc + 512 + col; }
                    u32x4 w; w.x = cvtpk(v0[0], v0[1]); w.y = cvtpk(v0[2], v0[3]); w.z = cvtpk(v1[0], v1[1]); w.w = cvtpk(v1[2], v1[3]);
                    *(u32x4*)dst = w; } }
    }
}

__device__ __forceinline__ void gemm_phase(LAS unsigned char* lds, const Gemm g, const StaticOrder& S, const EpiP& E) {
    const int tid = threadIdx.x, wid = __builtin_amdgcn_readfirstlane(tid >> 6), lane = tid & 63, wr = wid >> 2, wc = wid & 3, fr = lane & 15, fq = lane >> 4;
    const int K = g.K, nt = K / BK, lda = g.lda;
    unsigned voffA[2], voffB[2];
#pragma unroll
    for (int i = 0; i < 2; ++i) { int R, C; stage_rc(tid * 16 + i * 8192, R, C); const int Rb = E.perm ? ((R & ~31) + perm32(R & 31)) : R;
        voffA[i] = (unsigned)(R * lda + C) * 2u; voffB[i] = (unsigned)(Rb * K + C) * 2u; }
    const size_t kstep = (size_t)(BK * 2);
    const size_t hstepA = (size_t)HALF * lda * 2, hstepB = (size_t)HALF * K * 2;
    const size_t tstepA = 2 * hstepA, tstepB = 2 * hstepB;
    const unsigned ldsw = (unsigned)wid * 1024u;
    const int aoff = lds_byte(wr * 64 + fr, fq * 8), boff = lds_byte(wc * 32 + fr, fq * 8);
#define PG8_SA(b, h) (((b) * 2 + (h)) * HTB)
#define PG8_SB(b, h) ((4 + (b) * 2 + (h)) * HTB)
#define PG8_STAGE(bufoff, gbase, voff) do { _Pragma("unroll") for (int _i = 0; _i < 2; ++_i) \
        __builtin_amdgcn_global_load_lds((const unsigned*)((const char*)(gbase) + (voff)[_i]), (LAS unsigned*)(lds + (bufoff) + ldsw + _i * 8192), 16, 0, 0); } while (0)
#define PG8_LDA(dst, b, h) do { _Pragma("unroll") for (int m = 0; m < 4; ++m) _Pragma("unroll") for (int k = 0; k < 2; ++k) dst[m][k] = *(const LAS bf16x8*)(lds + PG8_SA(b, h) + aoff + m * 2048 + k * 1024); } while (0)
#define PG8_LDB(dst, b, h) do { _Pragma("unroll") for (int n = 0; n < 2; ++n) _Pragma("unroll") for (int k = 0; k < 2; ++k) dst[n][k] = *(const LAS bf16x8*)(lds + PG8_SB(b, h) + boff + n * 2048 + k * 1024); } while (0)
#define PG8_MMA(ai, bj, At, Bt) do { __builtin_amdgcn_s_setprio(1); _Pragma("unroll") for (int m = 0; m < 4; ++m) _Pragma("unroll") for (int n = 0; n < 2; ++n) _Pragma("unroll") for (int k = 0; k < 2; ++k) \
        acc[ai][bj][m][n] = __builtin_amdgcn_mfma_f32_16x16x32_bf16(Bt[n][k], At[m][k], acc[ai][bj][m][n], 0, 0, 0); __builtin_amdgcn_s_setprio(0); } while (0)
#define PG8_WAIT_V(n) asm volatile("s_waitcnt vmcnt(" #n ")" ::: "memory")
#define PG8_WAIT_L(n) asm volatile("s_waitcnt lgkmcnt(" #n ")" ::: "memory")
#define PG8_BAR __builtin_amdgcn_s_barrier()
#define PG8_SCHED __builtin_amdgcn_sched_barrier(0)
    Unit cur, nxt; int ui = 0;
    if (!S.next(0, cur)) return;
    f32x4 acc[2][2][4][2];
#pragma unroll
    for (int a = 0; a < 2; ++a)
#pragma unroll
        for (int b = 0; b < 2; ++b)
#pragma unroll
            for (int m = 0; m < 4; ++m)
#pragma unroll
                for (int n = 0; n < 2; ++n) acc[a][b][m][n] = (f32x4){0.f, 0.f, 0.f, 0.f};
    bf16x8 At[4][2], B0[2][2], B1[2][2];
    const char* cA = (const char*)g.A + (size_t)cur.pm * tstepA; const char* cB = (const char*)g.Bt + (size_t)cur.pn * tstepB;
    PG8_STAGE(PG8_SB(0, 0), cB, voffB); PG8_STAGE(PG8_SB(0, 1), cB + hstepB, voffB); PG8_STAGE(PG8_SA(0, 0), cA, voffA); PG8_STAGE(PG8_SA(0, 1), cA + hstepA, voffA);
    if (wr == 1) PG8_BAR;
    PG8_WAIT_V(2); PG8_BAR;
    PG8_STAGE(PG8_SB(1, 0), cB + kstep, voffB); PG8_STAGE(PG8_SA(1, 0), cA + kstep, voffA); PG8_STAGE(PG8_SB(1, 1), cB + hstepB + kstep, voffB);
    PG8_WAIT_V(6); PG8_BAR;
    for (;;) {
        const bool has_next = S.next(ui + 1, nxt);
        const char* nA = has_next ? (const char*)g.A + (size_t)nxt.pm * tstepA : cA; const char* nB = has_next ? (const char*)g.Bt + (size_t)nxt.pn * tstepB : cB;
        for (int t = 0; t < nt; t += 2) {
            const bool last = (t == nt - 2);
            const char* a1 = cA + (size_t)(t + 1) * kstep;
            const char* a2 = last ? nA : cA + (size_t)(t + 2) * kstep; const char* b2 = last ? nB : cB + (size_t)(t + 2) * kstep;
            const char* a3 = a2 + kstep; const char* b3 = b2 + kstep;
            PG8_LDB(B0, 0, 0); PG8_LDB(B1, 0, 1); PG8_SCHED; PG8_LDA(At, 0, 0); PG8_STAGE(PG8_SA(1, 1), a1 + hstepA, voffA);
            PG8_WAIT_V(8); PG8_WAIT_L(0); PG8_BAR; PG8_MMA(0, 0, At, B0); PG8_MMA(0, 1, At, B1); PG8_BAR; PG8_SCHED;
            PG8_LDA(At, 0, 1); PG8_STAGE(PG8_SB(0, 0), b2, voffB); PG8_STAGE(PG8_SB(0, 1), b2 + hstepB, voffB); PG8_STAGE(PG8_SA(0, 0), a2, voffA);
            PG8_WAIT_V(8); PG8_WAIT_L(0); PG8_BAR; PG8_MMA(1, 0, At, B0); PG8_MMA(1, 1, At, B1); PG8_BAR; PG8_SCHED;
            PG8_LDB(B0, 1, 0); PG8_LDB(B1, 1, 1); PG8_SCHED; PG8_LDA(At, 1, 0); PG8_STAGE(PG8_SA(0, 1), a2 + hstepA, voffA);
            PG8_WAIT_V(8); PG8_WAIT_L(0); PG8_BAR; PG8_MMA(0, 0, At, B0); PG8_MMA(0, 1, At, B1); PG8_BAR; PG8_SCHED;
            PG8_LDA(At, 1, 1); PG8_STAGE(PG8_SB(1, 0), b3, voffB); PG8_STAGE(PG8_SB(1, 1), b3 + hstepB, voffB); PG8_STAGE(PG8_SA(1, 0), a3, voffA);
            PG8_WAIT_V(8); PG8_WAIT_L(0); PG8_BAR; PG8_MMA(1, 0, At, B0); PG8_MMA(1, 1, At, B1); PG8_BAR; PG8_SCHED;
        }
        if (wr == 0) PG8_BAR;
        epi_run(E, acc, cur, wr, wc, fr, fq);
        if (!has_next) break;
#pragma unroll
        for (int a = 0; a < 2; ++a)
#pragma unroll
            for (int b = 0; b < 2; ++b)
#pragma unroll
                for (int m = 0; m < 4; ++m)
#pragma unroll
                    for (int n = 0; n < 2; ++n) acc[a][b][m][n] = (f32x4){0.f, 0.f, 0.f, 0.f};
        cur = nxt; cA = nA; cB = nB; ++ui;
        if (wr == 1) PG8_BAR;
    }
    PG8_WAIT_V(0);
    PG8_BAR;
#undef PG8_SA
#undef PG8_SB
#undef PG8_STAGE
#undef PG8_LDA
#undef PG8_LDB
#undef PG8_MMA
#undef PG8_WAIT_V
#undef PG8_WAIT_L
#undef PG8_BAR
#undef PG8_SCHED
}
}

typedef GAS unsigned gu32;
#define RLX_AGENT __ATOMIC_RELAXED, __HIP_MEMORY_SCOPE_AGENT
#define XB_TMO      128
#define XB_XCNT(j)  (256  + 64 * (j))
#define XB_XSUB(j)  (1280 + 64 * (j))
#define XB_XGEN(j)  (2304 + 64 * (j))
#define XB_TOP      3328
#define XB_TOPGEN   3392
#define XCD_BAR_WORDS 3456
#define XB_SPIN_CAP (1u << 18)
__device__ __forceinline__ unsigned xb_ld(unsigned* p)              { return __hip_atomic_load(p, __ATOMIC_RELAXED, __HIP_MEMORY_SCOPE_AGENT); }
__device__ __forceinline__ unsigned xb_add(unsigned* p, unsigned v) { return __hip_atomic_fetch_add(p, v, __ATOMIC_RELAXED, __HIP_MEMORY_SCOPE_AGENT); }
__device__ __forceinline__ unsigned xb_xcc_id() { return (unsigned)__builtin_amdgcn_s_getreg((3 << 11) | 20) & 0xFu; }
#define XB_SPIN(cond, bar) do { unsigned _sp = 0; while (cond) { __builtin_amdgcn_s_sleep(1); \
    if ((++_sp & 255u) == 0u) { if (xb_ld(&(bar)[XB_TMO])) break; if (_sp > XB_SPIN_CAP) { atomicAdd(&(bar)[XB_TMO], 1u); break; } } } } while (0)
struct XcdBarrier { unsigned* bar; unsigned x; volatile LAS unsigned* st; };
__device__ __forceinline__ XcdBarrier xcd_barrier_post(unsigned* bar, volatile LAS unsigned* st) {
    XcdBarrier b; b.bar = bar; b.x = xb_xcc_id(); b.st = st;
    if (threadIdx.x == 0) (void)xb_add(&bar[XB_XCNT(b.x)], 1u);
    return b;
}
__device__ __forceinline__ void xcd_barrier_complete(unsigned* bar, unsigned x, unsigned& nloc, unsigned& nx) {
    const unsigned G = gridDim.x * gridDim.y * gridDim.z;
    unsigned sum, cnt, mine, sp = 0u;
    for (;;) {
        sum = 0u; cnt = 0u; mine = 0u;
#pragma unroll
        for (unsigned j = 0; j < 16; ++j) { const unsigned c = xb_ld(&bar[XB_XCNT(j)]); sum += c; cnt += (c > 0u) ? 1u : 0u; mine = (j == x) ? c : mine; }
        if (sum == G) break;
        __builtin_amdgcn_s_sleep(1);
        if ((++sp & 255u) == 0u) { if (xb_ld(&bar[XB_TMO])) break; if (sp > XB_SPIN_CAP) { atomicAdd(&bar[XB_TMO], 1u); break; } }
    }
    nloc = mine > 0u ? mine : 1u; nx = cnt > 0u ? cnt : 1u;
}
__device__ __forceinline__ void xcd_barrier(const XcdBarrier& b) {
    asm volatile("s_waitcnt vmcnt(0)" ::: "memory");
    __syncthreads();
    if (threadIdx.x == 0) {
        unsigned* bar = b.bar;
        __builtin_amdgcn_s_waitcnt(0);
        unsigned nloc = b.st[0], nx = b.st[1];
        if (nloc == 0u) { xcd_barrier_complete(bar, b.x, nloc, nx); b.st[0] = nloc; b.st[1] = nx; }
        const unsigned old = xb_add(&bar[XB_XSUB(b.x)], 1u);
        const unsigned gen = old / nloc;
        if (old + 1u == (gen + 1u) * nloc) {
            __builtin_amdgcn_fence(__ATOMIC_RELEASE, "agent");
            asm volatile("s_waitcnt vmcnt(0)" ::: "memory");
            const unsigned og = xb_add(&bar[XB_TOP], 1u);
            const unsigned tg = og / nx;
            if (og + 1u == (tg + 1u) * nx) xb_add(&bar[XB_TOPGEN], 1u);
            else XB_SPIN(xb_ld(&bar[XB_TOPGEN]) == tg, bar);
            __builtin_amdgcn_fence(__ATOMIC_ACQUIRE, "agent");
            xb_add(&bar[XB_XGEN(b.x)], 1u);
            asm volatile("s_waitcnt vmcnt(0)" ::: "memory");
        } else {
            XB_SPIN(xb_ld(&bar[XB_XGEN(b.x)]) == gen, bar);
            __builtin_amdgcn_fence(__ATOMIC_ACQUIRE, "agent");
            asm volatile("s_waitcnt vmcnt(0)" ::: "memory");
        }
    }
    __syncthreads();
}

struct Args { const void* in[33]; float* out; unsigned char* ws; };
struct Frame {
    LAS unsigned char* lds;
    int tid, lane, wave, G, bid;
    const Args* a;
    unsigned char* ws;
};
#define INF(i) ((const float*)F.a->in[i])

__device__ __forceinline__ void transpose_item(const float* W, int K, int N, bf16_t* WT, int mapmode, int row_off, const float* kscale, LAS float* scr, int item, int lane) {
    const int nblk = N / 32, kb = item / nblk, nb = item % nblk, k0 = 64 * kb, n0 = 32 * nb;
#pragma unroll 8
    for (int i = 0; i < 32; ++i) { const int kk = 2 * i + (lane >> 5); scr[kk * 33 + (lane & 31)] = W[(size_t)(k0 + kk) * N + n0 + (lane & 31)]; }
    LDS_WAIT(); asm volatile("" ::: "memory");
    const int c = lane & 7;
    float sc[8];
#pragma unroll
    for (int i = 0; i < 8; ++i) sc[i] = kscale ? kscale[k0 + 8 * c + i] : 1.0f;
#pragma unroll
    for (int j = 0; j < 4; ++j) { const int n = (lane >> 3) + 8 * j; const LAS float* s = scr + (8 * c) * 33 + n;
        u32x4 o; o.x = cvtpk(s[0 * 33] * sc[0], s[1 * 33] * sc[1]); o.y = cvtpk(s[2 * 33] * sc[2], s[3 * 33] * sc[3]); o.z = cvtpk(s[4 * 33] * sc[4], s[5 * 33] * sc[5]); o.w = cvtpk(s[6 * 33] * sc[6], s[7 * 33] * sc[7]);
        const int nn = n0 + n; const int drow = mapmode ? ((nn >> 7) * 256 + (nn & 127) + row_off) : (nn + row_off);
        *(u32x4*)(WT + (size_t)drow * K + k0 + 8 * c) = o; }
    LDS_WAIT(); asm volatile("" ::: "memory");
}
__device__ __forceinline__ void modp_item(Frame& F, LAS float* cact, int item) {
    const int cg = item >> 3, ks = item & 7, l = cg / 96, j = (cg % 96) * 64 + F.lane;
    const float* c = INF(1);
#pragma unroll
    for (int i = 0; i < 16; ++i) { const int idx = F.lane + 64 * i, b = idx >> 7, kk = idx & 127; const float v = c[b * 1024 + ks * 128 + kk]; cact[idx] = v * sigmoidf_(v); }
    LDS_WAIT(); asm volatile("" ::: "memory");
    float acc[8];
#pragma unroll
    for (int b = 0; b < 8; ++b) acc[b] = 0.f;
    const float* w = INF(3) + ((size_t)l * 1024 + ks * 128) * 6144 + j;
#pragma unroll 8
    for (int kk = 0; kk < 128; ++kk) { const float wv = w[(size_t)kk * 6144];
#pragma unroll
        for (int b = 0; b < 8; ++b) acc[b] += cact[b * 128 + kk] * wv; }
    float* modp = (float*)(F.ws + WS_MODP);
    const float bias = (ks == 0) ? INF(4)[l * 6144 + j] : 0.f;
#pragma unroll
    for (int b = 0; b < 8; ++b) modp[((size_t)(ks * 2 + l) * 8 + b) * 6144 + j] = acc[b] + bias;
    LDS_WAIT(); asm volatile("" ::: "memory");
}
__device__ __forceinline__ void step_prep(Frame& F) {
    LAS float* scr = (LAS float*)(F.lds + F.wave * 16384);
    LAS float* cact = scr + 64 * 33;
    const int gw = F.bid * NWAVES + F.wave, NGW = F.G * NWAVES;
    constexpr int N_MODP = 192 * 8;
    constexpr int I_IN0 = 16 * 37, I_QUP = 6 * 24, I_KVUP = 4 * 32, I_GLU = 8 * 16, I_OUT = 16 * 32, I_G = 16 * 88, I_DN = 44 * 32, I_IN1 = 16 * 80;
    constexpr int NITEMS = N_MODP + I_IN0 + I_QUP + I_KVUP + I_GLU + 2 * I_OUT + 4 * I_G + 2 * I_DN + I_IN1;
    unsigned char* ws = F.ws;
    for (int it = gw; it < NITEMS; it += NGW) {
        int r = it;
        if (r < N_MODP) { modp_item(F, cact, r); continue; } r -= N_MODP;
        if (r < I_IN0) { transpose_item(INF(10), 1024, IN0, (bf16_t*)(ws + W_IN0), 0, 0, nullptr, scr, r, F.lane); continue; } r -= I_IN0;
        if (r < I_QUP) { transpose_item(INF(13), 384, 768, (bf16_t*)(ws + W_QUP), 0, 0, INF(11), scr, r, F.lane); continue; } r -= I_QUP;
        if (r < I_KVUP) { transpose_item(INF(14), 256, 1024, (bf16_t*)(ws + W_KVUP), 0, 0, INF(12), scr, r, F.lane); continue; } r -= I_KVUP;
        if (r < I_GLU) { transpose_item(INF(23), 512, 512, (bf16_t*)(ws + W_GLU), 0, 0, nullptr, scr, r, F.lane); continue; } r -= I_GLU;
        if (r < I_OUT) { transpose_item(INF(6), 1024, 1024, (bf16_t*)(ws + W_OUT0), 0, 0, nullptr, scr, r, F.lane); continue; } r -= I_OUT;
        if (r < I_OUT) { transpose_item(INF(6) + (size_t)D * D, 1024, 1024, (bf16_t*)(ws + W_OUT1), 0, 0, nullptr, scr, r, F.lane); continue; } r -= I_OUT;
        if (r < I_G) { transpose_item(INF(7), 1024, FFH, (bf16_t*)(ws + W_GU0), 1, 0, nullptr, scr, r, F.lane); continue; } r -= I_G;
        if (r < I_G) { transpose_item(INF(8), 1024, FFH, (bf16_t*)(ws + W_GU0), 1, 128, nullptr, scr, r, F.lane); continue; } r -= I_G;
        if (r < I_G) { transpose_item(INF(7) + (size_t)D * FFH, 1024, FFH, (bf16_t*)(ws + W_GU1), 1, 0, nullptr, scr, r, F.lane); continue; } r -= I_G;
        if (r < I_G) { transpose_item(INF(8) + (size_t)D * FFH, 1024, FFH, (bf16_t*)(ws + W_GU1), 1, 128, nullptr, scr, r, F.lane); continue; } r -= I_G;
        if (r < I_DN) { transpose_item(INF(9), FFH, 1024, (bf16_t*)(ws + W_DN0), 0, 0, nullptr, scr, r, F.lane); continue; } r -= I_DN;
        if (r < I_DN) { transpose_item(INF(9) + (size_t)FFH * D, FFH, 1024, (bf16_t*)(ws + W_DN1), 0, 0, nullptr, scr, r, F.lane); continue; } r -= I_DN;
        transpose_item(INF(25), 1024, IN1, (bf16_t*)(ws + W_IN1), 0, 0, nullptr, scr, r, F.lane);
    }
    { u32x4* p = (u32x4*)(ws + W_IN0 + (size_t)IN0 * D * 2); const int n16 = (IN0P - IN0) * D * 2 / 16;
      for (int i = F.bid * NTHR + F.tid; i < n16; i += F.G * NTHR) p[i] = (u32x4){0u, 0u, 0u, 0u}; }
}

__device__ __forceinline__ float row_sumsq(const f32x4 (&v)[4]) {
    float s = 0.f;
#pragma unroll
    for (int j = 0; j < 4; ++j) s += (v[j].x * v[j].x + v[j].y * v[j].y) + (v[j].z * v[j].z + v[j].w * v[j].w);
    return wave_sum(s);
}

__device__ __forceinline__ void step_xn0(Frame& F) {
    const float* modp = (const float*)(F.ws + WS_MODP);
    float* mod = (float*)(F.ws + WS_MOD);
    { const int e = F.bid * 384 + F.tid;
      if (F.tid < 384 && e < 98304) { float s = 0.f;
#pragma unroll
          for (int ks = 0; ks < 8; ++ks) s += modp[(size_t)ks * 98304 + e];
          mod[e] = s; } }
    LAS float* shv = (LAS float*)F.lds; LAS float* scv = shv + 1024;
    for (int rb = F.bid; rb < M / 64; rb += F.G) {
        const int b = (rb * 64) / SEQ;
        __syncthreads();
        for (int col = F.tid; col < 1024; col += NTHR) { float s0 = 0.f, s1 = 0.f;
#pragma unroll
            for (int ks = 0; ks < 8; ++ks) { const float* p = modp + ((size_t)(ks * 2 + 0) * 8 + b) * 6144; s0 += p[col]; s1 += p[1024 + col]; }
            shv[col] = s0; scv[col] = s1; }
        __syncthreads();
        const float* g0 = INF(5);
        for (int i = 0; i < 8; ++i) {
            const int row = rb * 64 + F.wave * 8 + i;
            const f32x4* xr = (const f32x4*)(INF(0) + (size_t)row * D) + F.lane;
            f32x4 v[4];
#pragma unroll
            for (int j = 0; j < 4; ++j) v[j] = xr[64 * j];
            const float rs = 1.0f / sqrtf(row_sumsq(v) * (1.0f / D) + RMS_EPS);
            u32x2* o = (u32x2*)((bf16_t*)(F.ws + WS_XN) + (size_t)row * D) + F.lane;
#pragma unroll
            for (int j = 0; j < 4; ++j) { const int col = 4 * F.lane + 256 * j; const f32x4 gg = *(const f32x4*)(g0 + col);
                float t[4];
#pragma unroll
                for (int k = 0; k < 4; ++k) t[k] = v[j][k] * rs * gg[k] * (1.0f + scv[col + k]) + shv[col + k];
                u32x2 w; w.x = cvtpk(t[0], t[1]); w.y = cvtpk(t[2], t[3]); o[64 * j] = w; }
        }
    }
}

__device__ __forceinline__ void step_norm(Frame& F, const float* Fin, const float* base, const float* gpost, int gate_off, int layer,
                                          bool has_next, const float* gpre, int nlayer, int sh_off, int sc_off) {
    const float* mod = (const float*)(F.ws + WS_MOD);
    const int gw = F.bid * NWAVES + F.wave, NGW = F.G * NWAVES;
    for (int row = gw; row < M; row += NGW) {
        const int b = row / SEQ;
        const f32x4* fr = (const f32x4*)(Fin + (size_t)row * D) + F.lane;
        const f32x4* br = (const f32x4*)(base + (size_t)row * D) + F.lane;
        f32x4 v[4], h[4];
#pragma unroll
        for (int j = 0; j < 4; ++j) { v[j] = fr[64 * j]; h[j] = br[64 * j]; }
        const float rs = 1.0f / sqrtf(row_sumsq(v) * (1.0f / D) + RMS_EPS);
        const float* gt = mod + ((size_t)layer * 8 + b) * 6144 + gate_off;
#pragma unroll
        for (int j = 0; j < 4; ++j) { const int col = 4 * F.lane + 256 * j; const f32x4 gp = *(const f32x4*)(gpost + col), ga = *(const f32x4*)(gt + col);
            h[j] = h[j] + ga * (v[j] * rs * gp); }
        f32x4* orow = (f32x4*)(F.a->out + (size_t)row * D) + F.lane;
#pragma unroll
        for (int j = 0; j < 4; ++j) orow[64 * j] = h[j];
        if (has_next) {
            const float rs2 = 1.0f / sqrtf(row_sumsq(h) * (1.0f / D) + RMS_EPS);
            const float* mn = mod + ((size_t)nlayer * 8 + b) * 6144;
            u32x2* o = (u32x2*)((bf16_t*)(F.ws + WS_XN) + (size_t)row * D) + F.lane;
#pragma unroll
            for (int j = 0; j < 4; ++j) { const int col = 4 * F.lane + 256 * j; const f32x4 gg = *(const f32x4*)(gpre + col), sh = *(const f32x4*)(mn + sh_off + col), sc = *(const f32x4*)(mn + sc_off + col);
                const f32x4 t = h[j] * rs2 * gg * (sc + 1.0f) + sh;
                u32x2 w; w.x = cvtpk(t[0], t[1]); w.y = cvtpk(t[2], t[3]); o[64 * j] = w; }
        }
    }
}

__device__ __forceinline__ void step_r2(Frame& F) {
    const bf16_t* proj = (const bf16_t*)(F.ws + WS_PROJ0);
    float* rsq = (float*)(F.ws + WS_RS); float* rskv = rsq + M;
    bf16_t* k96 = (bf16_t*)(F.ws + WS_K96);
    const int* pos = (const int*)F.a->in[2];
    const int gw = F.bid * NWAVES + F.wave, NGW = F.G * NWAVES;
    for (int row = gw; row < M; row += NGW) {
        const bf16_t* p = proj + (size_t)row * IN0P;
        const unsigned* pq = (const unsigned*)(p + 6 * F.lane);
        float sq = 0.f;
#pragma unroll
        for (int i = 0; i < 3; ++i) { const unsigned w = pq[i]; const float a = bflo(w), b = bfhi(w); sq += a * a + b * b; }
        const u32x2 wk = *(const u32x2*)(p + 384 + 4 * F.lane);
        float sk = bflo(wk.x) * bflo(wk.x) + bfhi(wk.x) * bfhi(wk.x) + bflo(wk.y) * bflo(wk.y) + bfhi(wk.y) * bfhi(wk.y);
        sq = wave_sum(sq); sk = wave_sum(sk);
        if (F.lane == 0) { rsq[row] = 1.0f / sqrtf(sq * (1.0f / 384.0f) + RMS_EPS); rskv[row] = 1.0f / sqrtf(sk * (1.0f / 256.0f) + RMS_EPS); }
        const float x = bf2f(p[640 + (F.lane & 31)]);
        const float other = __shfl_xor(x, 16);
        const int i = F.lane & 15;
        const float inv = exp2f(-(float)i * (13.287712379549449f / 16.0f));
        const float ang = (float)pos[row] * inv;
        float sn, cs; sincosf(ang, &sn, &cs);
        const float o = (F.lane & 16) ? (x * cs + other * sn) : (x * cs - other * sn);
        const unsigned short ob = (unsigned short)(cvtpk(o, o) & 0xffffu);
        if (F.lane < 32) {
#pragma unroll
            for (int h = 0; h < 8; ++h) k96[(size_t)row * 768 + h * 96 + 64 + F.lane] = ob;
        }
    }
}

template <int DK, int MODE>
__device__ __forceinline__ void attn_unit(LAS unsigned char* lds, const bf16_t* Q, int ldq, const bf16_t* K, int ldk, const bf16_t* V, int ldv, bf16_t* O, int ldo,
                                          int b, int qb, const int* pos, int tid) {
    constexpr int NS = DK / 16, KS = DK * 2 + 16, KCH = DK / 8;
    const int lane = tid & 63, r32 = lane & 31, hi = lane >> 5; const int wid = __builtin_amdgcn_readfirstlane(tid >> 6);
    const int rowbase = b * SEQ, q0 = qb * 256, qrow = q0 + wid * 32 + r32;
    LAS unsigned char* Ks = lds; LAS unsigned char* Vs = lds + 16384;
    bf16x8 qf[NS];
    { const bf16_t* qp = Q + (size_t)(rowbase + qrow) * ldq + 8 * hi;
#pragma unroll
      for (int s = 0; s < NS; ++s) qf[s] = *(const bf16x8*)(qp + 16 * s); }
    if (MODE == 0) {
        const float p = (float)pos[rowbase + qrow];
#pragma unroll
        for (int j = 0; j < 8; ++j) { const int i = 8 * hi + j; const float inv = exp2f(-(float)i * (13.287712379549449f / 16.0f));
            float sn, cs; sincosf(p * inv, &sn, &cs);
            const float x1 = bf2f((unsigned short)qf[NS - 2][j]), x2 = bf2f((unsigned short)qf[NS - 1][j]);
            const unsigned w = cvtpk(x1 * cs - x2 * sn, x2 * cs + x1 * sn);
            qf[NS - 2][j] = (short)(w & 0xffffu); qf[NS - 1][j] = (short)(w >> 16); }
    }
    f32x16 o0, o1;
#pragma unroll
    for (int r = 0; r < 16; ++r) { o0[r] = 0.f; o1[r] = 0.f; }
    float mrun = -INFINITY, lrun = 0.f, R = 0.f;
    const int NT = (q0 + 256) / 64;
    const int vaddr = ((lane >> 4) & 1) * 32 + (lane & 3) * 8 + (4 * hi + ((lane & 15) >> 2)) * 64;
    for (int it = 0; it < NT; ++it) {
        const int kt = (MODE == 0) ? it : (NT - 1 - it), k0 = kt * 64;
        __syncthreads();
        for (int c = tid; c < 64 * KCH; c += NTHR) { const int key = c / KCH, part = c % KCH;
            const u32x4 v = *(const u32x4*)(K + (size_t)(rowbase + k0 + key) * ldk + 8 * part); *(LAS u32x4*)(Ks + key * KS + 16 * part) = v; }
        { const int key = tid >> 3, dch = tid & 7; const u32x4 v = *(const u32x4*)(V + (size_t)(rowbase + k0 + key) * ldv + 8 * dch);
          *(LAS u32x4*)(Vs + (dch >> 2) * 4096 + key * 64 + (dch & 3) * 16) = v; }
        __syncthreads();
        if (k0 > q0 + wid * 32 + 31) continue;
        f32x16 p0, p1;
#pragma unroll
        for (int r = 0; r < 16; ++r) { p0[r] = 0.f; p1[r] = 0.f; }
#pragma unroll
        for (int s = 0; s < NS; ++s) { const bf16x8 a0 = *(const LAS bf16x8*)(Ks + r32 * KS + 32 * s + 16 * hi), a1 = *(const LAS bf16x8*)(Ks + (32 + r32) * KS + 32 * s + 16 * hi);
            p0 = __builtin_amdgcn_mfma_f32_32x32x16_bf16(a0, qf[s], p0, 0, 0, 0); p1 = __builtin_amdgcn_mfma_f32_32x32x16_bf16(a1, qf[s], p1, 0, 0, 0); }
        if (MODE == 0) {
            const float c2 = 0.10206207261596577f * LOG2E;
            float rm = -INFINITY;
#pragma unroll
            for (int r = 0; r < 16; ++r) { const int key = k0 + crow(r, hi);
                p0[r] = (key > qrow) ? -INFINITY : p0[r] * c2; p1[r] = (key + 32 > qrow) ? -INFINITY : p1[r] * c2;
                rm = fmaxf(rm, fmaxf(p0[r], p1[r])); }
            rm = fmaxf(rm, __shfl_xor(rm, 32));
            const float mn = fmaxf(mrun, rm), alpha = ex2(mrun - mn);
            float ls = 0.f;
#pragma unroll
            for (int r = 0; r < 16; ++r) { p0[r] = ex2(p0[r] - mn); p1[r] = ex2(p1[r] - mn); ls += p0[r] + p1[r]; }
            lrun = lrun * alpha + ls; mrun = mn;
#pragma unroll
            for (int r = 0; r < 16; ++r) { o0[r] *= alpha; o1[r] *= alpha; }
        } else {
            float lb0[16], lb1[16];
#pragma unroll
            for (int r = 0; r < 16; ++r) { const int key = k0 + crow(r, hi);
                { const float z = p0[r] * 0.125f; const float sp = lg2(1.0f + ex2(-fabsf(z) * LOG2E)) * LN2; const float lb = fminf(z, 0.f) - sp; lb0[r] = lb; p0[r] = (key >= qrow) ? 0.f : (lb - z); }
                { const float z = p1[r] * 0.125f; const float sp = lg2(1.0f + ex2(-fabsf(z) * LOG2E)) * LN2; const float lb = fminf(z, 0.f) - sp; lb1[r] = lb; p1[r] = (key + 32 >= qrow) ? 0.f : (lb - z); } }
            float T[16]; const unsigned him = (unsigned)(-hi);
#pragma unroll
            for (int a = 0; a < 4; ++a) { const float g0 = (p0[4 * a] + p0[4 * a + 1]) + (p0[4 * a + 2] + p0[4 * a + 3]), g1 = (p1[4 * a] + p1[4 * a + 1]) + (p1[4 * a + 2] + p1[4 * a + 3]);
                const float q0_ = __shfl_xor(g0, 32), q1_ = __shfl_xor(g1, 32);
                T[2 * a] = bsel(him, q0_, g0); T[2 * a + 1] = bsel(him, g0, q0_); T[8 + 2 * a] = bsel(him, q1_, g1); T[8 + 2 * a + 1] = bsel(him, g1, q1_); }
            float suf[16]; suf[15] = 0.f;
#pragma unroll
            for (int i = 14; i >= 0; --i) suf[i] = suf[i + 1] + T[i + 1];
            const float total = suf[0] + T[0];
#pragma unroll
            for (int a = 0; a < 4; ++a) {
                { float s = R + bsel(him, suf[2 * a + 1], suf[2 * a]);
#pragma unroll
                  for (int i = 3; i >= 0; --i) { const int r = 4 * a + i; const int key = k0 + crow(r, hi); const float l1 = p0[r]; p0[r] = (key >= qrow) ? 0.f : ex2((lb0[r] + s) * LOG2E); s += l1; } }
                { float s = R + bsel(him, suf[8 + 2 * a + 1], suf[8 + 2 * a]);
#pragma unroll
                  for (int i = 3; i >= 0; --i) { const int r = 4 * a + i; const int key = k0 + 32 + crow(r, hi); const float l1 = p1[r]; p1[r] = (key >= qrow) ? 0.f : ex2((lb1[r] + s) * LOG2E); s += l1; } }
            }
            R += total;
        }
        bf16x8 pa[4];
        { u32x4 w;
          w.x = cvtpk(p0[0], p0[1]); w.y = cvtpk(p0[2], p0[3]); w.z = cvtpk(p0[4], p0[5]); w.w = cvtpk(p0[6], p0[7]); pa[0] = __builtin_bit_cast(bf16x8, w);
          w.x = cvtpk(p0[8], p0[9]); w.y = cvtpk(p0[10], p0[11]); w.z = cvtpk(p0[12], p0[13]); w.w = cvtpk(p0[14], p0[15]); pa[1] = __builtin_bit_cast(bf16x8, w);
          w.x = cvtpk(p1[0], p1[1]); w.y = cvtpk(p1[2], p1[3]); w.z = cvtpk(p1[4], p1[5]); w.w = cvtpk(p1[6], p1[7]); pa[2] = __builtin_bit_cast(bf16x8, w);
          w.x = cvtpk(p1[8], p1[9]); w.y = cvtpk(p1[10], p1[11]); w.z = cvtpk(p1[12], p1[13]); w.w = cvtpk(p1[14], p1[15]); pa[3] = __builtin_bit_cast(bf16x8, w); }
#pragma unroll
        for (int dt = 0; dt < 2; ++dt)
#pragma unroll
            for (int s = 0; s < 4; ++s) {
                const LAS unsigned char* vp = Vs + dt * 4096 + s * 1024 + vaddr;
                const s16x4 lo = __builtin_bit_cast(s16x4, __builtin_amdgcn_ds_read_tr16_b64_v4i16((LAS s16x4*)vp));
                const s16x4 hh = __builtin_bit_cast(s16x4, __builtin_amdgcn_ds_read_tr16_b64_v4i16((LAS s16x4*)(vp + 512)));
                const bf16x8 vf = (bf16x8){lo[0], lo[1], lo[2], lo[3], hh[0], hh[1], hh[2], hh[3]};
                if (dt == 0) o0 = __builtin_amdgcn_mfma_f32_32x32x16_bf16(vf, pa[s], o0, 0, 0, 0);
                else o1 = __builtin_amdgcn_mfma_f32_32x32x16_bf16(vf, pa[s], o1, 0, 0, 0);
            }
    }
    float inv = 1.0f;
    if (MODE == 0) { const float lt = lrun + __shfl_xor(lrun, 32); inv = 1.0f / lt; }
    bf16_t* op = O + (size_t)(rowbase + qrow) * ldo;
#pragma unroll
    for (int rg = 0; rg < 4; ++rg) {
        u32x2 w0, w1;
        w0.x = cvtpk(o0[4 * rg] * inv, o0[4 * rg + 1] * inv); w0.y = cvtpk(o0[4 * rg + 2] * inv, o0[4 * rg + 3] * inv);
        w1.x = cvtpk(o1[4 * rg] * inv, o1[4 * rg + 1] * inv); w1.y = cvtpk(o1[4 * rg + 2] * inv, o1[4 * rg + 3] * inv);
        *(u32x2*)(op + 8 * rg + 4 * hi) = w0; *(u32x2*)(op + 32 + 8 * rg + 4 * hi) = w1;
    }
}

__device__ __forceinline__ void s5_unit(Frame& F, int b, int g) {
    const int tid = F.tid, p = tid & 63, sub = __builtin_amdgcn_readfirstlane(tid >> 6);
    LAS float* us = (LAS float*)F.lds;
    LAS float* E = us + 2048;
    LAS float* Hre = E + 1024;
    LAS float* Him = Hre + 128 * 65;
    LAS float* Cre = Him + 128 * 65;
    LAS float* Cim = Cre + 1024;
    LAS float* Dsk = Cim + 1024;
    __syncthreads();
    for (int i = tid; i < 1024; i += NTHR) { const int c = i >> 6, pp = i & 63; Cre[pp * 16 + c] = INF(20)[(g * 16 + c) * 64 + pp]; Cim[pp * 16 + c] = INF(21)[(g * 16 + c) * 64 + pp]; }
    if (tid < 16) Dsk[tid] = INF(22)[g * 16 + tid];
    const float lre = fminf(INF(15)[g * 64 + p], -1e-4f), lim = INF(16)[g * 64 + p], dt = expf(INF(17)[g]);
    const float mag = expf(lre * dt); float sn, cs; sincosf(lim * dt, &sn, &cs);
    const float lbr = mag * cs, lbi = mag * sn;
    const float sh = sinf(0.5f * lim * dt);
    const float nr = expm1f(lre * dt) * cs - 2.0f * sh * sh, ni = lbi;
    const float den = 1.0f / (lre * lre + lim * lim);
    const float fr = (nr * lre + ni * lim) * den, fi = (ni * lre - nr * lim) * den;
    float bbr[16], bbi[16];
#pragma unroll
    for (int c = 0; c < 16; ++c) { const float br = INF(18)[(g * 64 + p) * 16 + c], bi = INF(19)[(g * 64 + p) * 16 + c]; bbr[c] = fr * br - fi * bi; bbi[c] = fr * bi + fi * br; }
    float l16r = lbr, l16i = lbi;
#pragma unroll
    for (int i = 0; i < 4; ++i) { const float r = l16r * l16r - l16i * l16i, im = 2.0f * l16r * l16i; l16r = r; l16i = im; }
    float cr = 0.f, ci = 0.f;
    const bf16_t* proj = (const bf16_t*)(F.ws + WS_PROJ0);
    bf16_t* Y = (bf16_t*)(F.ws + WS_Y);
    const int rowbase = b * SEQ;
    for (int seg = 0; seg < SEQ / 128; ++seg) {
        const int t_ld = tid >> 2, c4 = (tid & 3) * 4;
        { const u32x2 w = *(const u32x2*)(proj + (size_t)(rowbase + seg * 128 + t_ld) * IN0P + 672 + g * 16 + c4);
          us[t_ld * 16 + c4] = bflo(w.x); us[t_ld * 16 + c4 + 1] = bfhi(w.x); us[t_ld * 16 + c4 + 2] = bflo(w.y); us[t_ld * 16 + c4 + 3] = bfhi(w.y); }
        __syncthreads();
        float bur[16], bui[16]; float er = 0.f, ei = 0.f;
#pragma unroll
        for (int j = 0; j < 16; ++j) { float ur = 0.f, ui = 0.f;
#pragma unroll
            for (int c = 0; c < 16; ++c) { const float u = us[(sub * 16 + j) * 16 + c]; ur += u * bbr[c]; ui += u * bbi[c]; }
            bur[j] = ur; bui[j] = ui;
            const float nr_ = lbr * er - lbi * ei + ur, ni_ = lbr * ei + lbi * er + ui; er = nr_; ei = ni_; }
        E[(sub * 64 + p) * 2] = er; E[(sub * 64 + p) * 2 + 1] = ei;
        __syncthreads();
        float hr = 0.f, hi_ = 0.f;
        { float sr = cr, si = ci;
#pragma unroll
          for (int k = 0; k < 8; ++k) { if (k == sub) { hr = sr; hi_ = si; }
              const float e_r = E[(k * 64 + p) * 2], e_i = E[(k * 64 + p) * 2 + 1];
              const float nr_ = l16r * sr - l16i * si + e_r, ni_ = l16r * si + l16i * sr + e_i; sr = nr_; si = ni_; }
          cr = sr; ci = si; }
#pragma unroll
        for (int j = 0; j < 16; ++j) { const float nr_ = lbr * hr - lbi * hi_ + bur[j], ni_ = lbr * hi_ + lbi * hr + bui[j]; hr = nr_; hi_ = ni_;
            Hre[(sub * 16 + j) * 65 + p] = hr; Him[(sub * 16 + j) * 65 + p] = hi_; }
        __syncthreads();
        { float y[4] = {0.f, 0.f, 0.f, 0.f};
          for (int pp = 0; pp < 64; ++pp) { const float h_r = Hre[t_ld * 65 + pp], h_i = Him[t_ld * 65 + pp];
              const f32x4 c_r = *(const LAS f32x4*)(Cre + pp * 16 + c4), c_i = *(const LAS f32x4*)(Cim + pp * 16 + c4);
#pragma unroll
              for (int k = 0; k < 4; ++k) y[k] += c_r[k] * h_r - c_i[k] * h_i; }
#pragma unroll
          for (int k = 0; k < 4; ++k) y[k] = gelu_tanh(y[k] + Dsk[c4 + k] * us[t_ld * 16 + c4 + k]);
          u32x2 w; w.x = cvtpk(y[0], y[1]); w.y = cvtpk(y[2], y[3]);
          *(u32x2*)(Y + (size_t)(rowbase + seg * 128 + t_ld) * 512 + g * 16 + c4) = w; }
        __syncthreads();
    }
}

__device__ __forceinline__ void lru_unit(Frame& F, int b, int n) {
    const int tid = F.tid, c = tid & 63, sub = __builtin_amdgcn_readfirstlane(tid >> 6);
    LAS float* XC = (LAS float*)F.lds;
    LAS float* WA = XC + 8192;
    LAS float* WX = WA + 4096;
    LAS float* PE = WX + 4096;
    __syncthreads();
    for (int i = tid; i < 4096; i += NTHR) { WA[i] = INF(28)[n * 4096 + i]; WX[i] = INF(30)[n * 4096 + i]; }
    const int ch = n * 64 + c;
    float cw[4];
#pragma unroll
    for (int i = 0; i < 4; ++i) cw[i] = INF(26)[i * 512 + ch];
    const float cb = INF(27)[ch], ba = INF(29)[ch], bx = INF(31)[ch];
    const float lam = INF(32)[ch];
    const float ls = fminf(lam, 0.f) - log1pf(expf(-fabsf(lam)));
    const bf16_t* proj = (const bf16_t*)(F.ws + WS_PROJ1);
    bf16_t* mix = (bf16_t*)(F.ws + WS_MIX);
    const int rowbase = b * SEQ;
    float carry = 0.f;
    __syncthreads();
    for (int seg = 0; seg < SEQ / 128; ++seg) {
        const int T0 = seg * 128 + sub * 16;
        float xr[19];
#pragma unroll
        for (int k = 0; k < 19; ++k) { const int T = T0 - 3 + k; xr[k] = (T >= 0) ? bf2f(proj[(size_t)(rowbase + T) * IN1 + 1536 + ch]) : 0.f; }
        float xc[16];
#pragma unroll
        for (int j = 0; j < 16; ++j) { xc[j] = cb + cw[0] * xr[j] + cw[1] * xr[j + 1] + cw[2] * xr[j + 2] + cw[3] * xr[j + 3]; XC[(sub * 16 + j) * 64 + c] = xc[j]; }
        __syncthreads();
        float av[16], iv[16];
#pragma unroll
        for (int q4 = 0; q4 < 4; ++q4) {
            float ra[4] = {0.f, 0.f, 0.f, 0.f}, ia[4] = {0.f, 0.f, 0.f, 0.f};
            for (int cc = 0; cc < 64; ++cc) { const float wa = WA[cc * 64 + c], wx = WX[cc * 64 + c];
#pragma unroll
                for (int q = 0; q < 4; ++q) { const float x = XC[(sub * 16 + q4 * 4 + q) * 64 + cc]; ra[q] += x * wa; ia[q] += x * wx; } }
#pragma unroll
            for (int q = 0; q < 4; ++q) { const int j = q4 * 4 + q; const float r = sigmoidf_(ra[q] + ba), ig = sigmoidf_(ia[q] + bx);
                const float log_a = 8.0f * r * ls; av[j] = expf(log_a); iv[j] = sqrtf(-expm1f(2.0f * log_a)) * (ig * xc[j]); }
        }
        float P = 1.f, e = 0.f;
#pragma unroll
        for (int j = 0; j < 16; ++j) { e = av[j] * e + iv[j]; P *= av[j]; }
        PE[(sub * 64 + c) * 2] = P; PE[(sub * 64 + c) * 2 + 1] = e;
        __syncthreads();
        float h = 0.f;
        { float s = carry;
#pragma unroll
          for (int k = 0; k < 8; ++k) { if (k == sub) h = s; s = PE[(k * 64 + c) * 2] * s + PE[(k * 64 + c) * 2 + 1]; }
          carry = s; }
#pragma unroll
        for (int j = 0; j < 16; ++j) { h = av[j] * h + iv[j];
            const size_t row = (size_t)(rowbase + T0 + j);
            const float yg = bf2f(proj[row * IN1 + 2048 + ch]);
            const float o = h * gelu_tanh(yg);
            mix[row * D + 512 + ch] = (unsigned short)(cvtpk(o, o) & 0xffffu); }
        __syncthreads();
    }
}

enum { ST_PREP = 0, ST_XN0, ST_IN0, ST_R2, ST_S5, ST_QUP, ST_KVUP, ST_MLA, ST_GLU, ST_OUT0, ST_NORM0A, ST_GU0, ST_DN0, ST_NORM0B,
       ST_IN1, ST_SB, ST_LRU, ST_OUT1, ST_NORM1A, ST_GU1, ST_DN1, ST_NORM1B, ST_COUNT };
__host__ __device__ constexpr bool bar_after(int st) { return !(st == ST_S5 || st == ST_QUP || st == ST_MLA || st == ST_SB); }

template <int ST> __device__ __forceinline__ void run_step(Frame& F) {
    unsigned char* ws = F.ws;
    bool is_gemm = false; pg8::Gemm g{}; pg8::EpiP e{};
    if constexpr (ST == ST_PREP) step_prep(F);
    else if constexpr (ST == ST_XN0) step_xn0(F);
    else if constexpr (ST == ST_IN0) { g = {(const bf16_t*)(ws + WS_XN), (const bf16_t*)(ws + W_IN0), M, IN0P, 1024, 1024}; e.mode = pg8::EM_BF16; e.perm = 1; e.O = ws + WS_PROJ0; e.ldc = IN0P; is_gemm = true; }
    else if constexpr (ST == ST_R2) step_r2(F);
    else if constexpr (ST == ST_S5) { for (int u = F.bid; u < 256; u += F.G) s5_unit(F, u >> 5, u & 31); __syncthreads(); }
    else if constexpr (ST == ST_QUP) { g = {(const bf16_t*)(ws + WS_PROJ0), (const bf16_t*)(ws + W_QUP), M, 768, 384, IN0P}; e.mode = pg8::EM_BF16; e.perm = 1; e.O = ws + WS_Q; e.ldc = 768; e.rs = (const float*)(ws + WS_RS); is_gemm = true; }
    else if constexpr (ST == ST_KVUP) { g = {(const bf16_t*)(ws + WS_PROJ0) + 384, (const bf16_t*)(ws + W_KVUP), M, 1024, 256, IN0P}; e.mode = pg8::EM_KV; e.perm = 1; e.O = ws + WS_K96; e.O2 = ws + WS_V; e.rs = (const float*)(ws + WS_RS) + M; is_gemm = true; }
    else if constexpr (ST == ST_MLA) {
        for (int u = F.bid; u < 256; u += F.G) { const int bh = u >> 2, pr = u & 3, b = bh >> 3, h = bh & 7;
            for (int k = 0; k < 2; ++k) { const int qb = k ? 7 - pr : pr;
                attn_unit<96, 0>(F.lds, (const bf16_t*)(ws + WS_Q) + h * 96, 768, (const bf16_t*)(ws + WS_K96) + h * 96, 768, (const bf16_t*)(ws + WS_V) + h * 64, 512,
                                 (bf16_t*)(ws + WS_MIX) + h * 64, 1024, b, qb, (const int*)F.a->in[2], F.tid); } }
        __syncthreads(); }
    else if constexpr (ST == ST_GLU) { g = {(const bf16_t*)(ws + WS_Y), (const bf16_t*)(ws + W_GLU), M, 512, 512, 512}; e.mode = pg8::EM_GLU; e.perm = 1; e.O = ws + WS_MIX; e.ldc = 1024; e.bias = INF(24); e.Yin = (const bf16_t*)(ws + WS_Y); is_gemm = true; }
    else if constexpr (ST == ST_OUT0) { g = {(const bf16_t*)(ws + WS_MIX), (const bf16_t*)(ws + W_OUT0), M, 1024, 1024, 1024}; e.mode = pg8::EM_F32; e.perm = 0; e.O = ws + WS_FOUT; e.ldc = 1024; is_gemm = true; }
    else if constexpr (ST == ST_NORM0A) step_norm(F, (const float*)(ws + WS_FOUT), INF(0), INF(5) + 1 * D, 2048, 0, true, INF(5) + 2 * D, 0, 3072, 4096);
    else if constexpr (ST == ST_GU0) { g = {(const bf16_t*)(ws + WS_XN), (const bf16_t*)(ws + W_GU0), M, 2 * FFH, 1024, 1024}; e.mode = pg8::EM_SWIGLU; e.perm = 1; e.O = ws + WS_HID; e.ldc = FFH; is_gemm = true; }
    else if constexpr (ST == ST_DN0) { g = {(const bf16_t*)(ws + WS_HID), (const bf16_t*)(ws + W_DN0), M, 1024, FFH, FFH}; e.mode = pg8::EM_F32; e.perm = 0; e.O = ws + WS_FDN; e.ldc = 1024; is_gemm = true; }
    else if constexpr (ST == ST_NORM0B) step_norm(F, (const float*)(ws + WS_FDN), F.a->out, INF(5) + 3 * D, 5120, 0, true, INF(5) + 4 * D, 1, 0, 1024);
    else if constexpr (ST == ST_IN1) { g = {(const bf16_t*)(ws + WS_XN), (const bf16_t*)(ws + W_IN1), M, IN1, 1024, 1024}; e.mode = pg8::EM_BF16; e.perm = 1; e.O = ws + WS_PROJ1; e.ldc = IN1; is_gemm = true; }
    else if constexpr (ST == ST_SB) {
        for (int u = F.bid; u < 256; u += F.G) { const int bh = u >> 2, pr = u & 3, b = bh >> 3, h = bh & 7;
            for (int k = 0; k < 2; ++k) { const int qb = k ? 7 - pr : pr;
                attn_unit<64, 1>(F.lds, (const bf16_t*)(ws + WS_PROJ1) + h * 64, IN1, (const bf16_t*)(ws + WS_PROJ1) + 512 + h * 64, IN1, (const bf16_t*)(ws + WS_PROJ1) + 1024 + h * 64, IN1,
                                 (bf16_t*)(ws + WS_MIX) + h * 64, 1024, b, qb, (const int*)F.a->in[2], F.tid); } }
        __syncthreads(); }
    else if constexpr (ST == ST_LRU) { for (int u = F.bid; u < 64; u += F.G) lru_unit(F, u >> 3, u & 7); __syncthreads(); }
    else if constexpr (ST == ST_OUT1) { g = {(const bf16_t*)(ws + WS_MIX), (const bf16_t*)(ws + W_OUT1), M, 1024, 1024, 1024}; e.mode = pg8::EM_F32; e.perm = 0; e.O = ws + WS_FOUT; e.ldc = 1024; is_gemm = true; }
    else if constexpr (ST == ST_NORM1A) step_norm(F, (const float*)(ws + WS_FOUT), F.a->out, INF(5) + 5 * D, 2048, 1, true, INF(5) + 6 * D, 1, 3072, 4096);
    else if constexpr (ST == ST_GU1) { g = {(const bf16_t*)(ws + WS_XN), (const bf16_t*)(ws + W_GU1), M, 2 * FFH, 1024, 1024}; e.mode = pg8::EM_SWIGLU; e.perm = 1; e.O = ws + WS_HID; e.ldc = FFH; is_gemm = true; }
    else if constexpr (ST == ST_DN1) { g = {(const bf16_t*)(ws + WS_HID), (const bf16_t*)(ws + W_DN1), M, 1024, FFH, FFH}; e.mode = pg8::EM_F32; e.perm = 0; e.O = ws + WS_FDN; e.ldc = 1024; is_gemm = true; }
    else if constexpr (ST == ST_NORM1B) step_norm(F, (const float*)(ws + WS_FDN), F.a->out, INF(5) + 7 * D, 5120, 1, false, nullptr, 0, 0, 0);
    if (is_gemm) { pg8::StaticOrder S; S.init(g.M, g.N, F.G, F.bid); pg8::gemm_phase(F.lds, g, S, e); }
}

template <int ST, int HI> struct StepSeq {
    template <class BarT> static __device__ __forceinline__ void run(Frame& F, const BarT& bar) {
        run_step<ST>(F);
        if constexpr (ST + 1 < HI) {
#if MK_SINGLE
            if constexpr (bar_after(ST)) xcd_barrier(bar);
#endif
            StepSeq<ST + 1, HI>::run(F, bar);
        }
    }
};

template <int LO, int HI>
__global__ void __launch_bounds__(NTHR, 2) trunk_fwd(Args args) {
    extern __shared__ __attribute__((aligned(16))) unsigned char lds[];
    Frame F;
    F.lds = (LAS unsigned char*)lds; F.tid = threadIdx.x; F.lane = F.tid & 63; F.wave = __builtin_amdgcn_readfirstlane(F.tid >> 6);
    F.G = gridDim.x; F.bid = blockIdx.x; F.a = &args; F.ws = args.ws;
    volatile LAS unsigned* MISC = (volatile LAS unsigned*)(F.lds + MISC_OFF);
    for (int u = F.tid; u < (LDS_BYTES - LDSCTL_OFF) / 4; u += NTHR) ((LAS unsigned*)(F.lds + LDSCTL_OFF))[u] = 0u;
    __syncthreads();
#if MK_SINGLE
    XcdBarrier bar = xcd_barrier_post((unsigned*)(args.ws + WS_CTL) + 4096, MISC + 8);
#else
    int bar = 0; (void)MISC;
#endif
    StepSeq<LO, HI>::run(F, bar);
}

template <int LO, int HI> static void launch_range(int grid, const Args& a, hipStream_t stream) {
    static bool attr = false;
    if (!attr) { (void)hipFuncSetAttribute((const void*)trunk_fwd<LO, HI>, hipFuncAttributeMaxDynamicSharedMemorySize, LDS_BYTES); attr = true; }
    hipLaunchKernelGGL((trunk_fwd<LO, HI>), dim3(grid), dim3(NTHR), LDS_BYTES, stream, a);
}
extern "C" void kernel_launch(void* const* d_in, const int* in_sizes, int n_in, void* d_out, int out_size, void* d_ws, size_t ws_size, hipStream_t stream) {
    static int grid = 0;
    if (grid == 0) {
        if (n_in != 33 || out_size != M * D || ws_size < WS_END) { fprintf(stderr, "kernel_launch: unexpected shapes (n_in %d out %d ws %zu)\n", n_in, out_size, ws_size); grid = -1; return; }
        int dev = 0, cus = 0, per_cu = 0;
        if (hipGetDevice(&dev) != hipSuccess || hipDeviceGetAttribute(&cus, hipDeviceAttributeMultiprocessorCount, dev) != hipSuccess) { grid = -1; return; }
#if MK_SINGLE
        if (hipFuncSetAttribute((const void*)trunk_fwd<0, ST_COUNT>, hipFuncAttributeMaxDynamicSharedMemorySize, LDS_BYTES) != hipSuccess) { fprintf(stderr, "kernel_launch: hipFuncSetAttribute failed\n"); grid = -1; return; }
        if (hipOccupancyMaxActiveBlocksPerMultiprocessor(&per_cu, (const void*)trunk_fwd<0, ST_COUNT>, NTHR, LDS_BYTES) != hipSuccess || per_cu < 1) { fprintf(stderr, "kernel_launch: occupancy query says %d blocks/CU\n", per_cu); (void)hipGetLastError(); grid = -1; return; }
#else
        (void)per_cu;
#endif
        grid = cus;
    }
    if (grid < 0) return;
    (void)hipMemsetAsync((char*)d_ws + WS_CTL, 0, CTL_ZERO_BYTES, stream);
    Args a{};
    for (int i = 0; i < 33; ++i) a.in[i] = d_in[i];
    a.out = (float*)d_out; a.ws = (unsigned char*)d_ws;
#if MK_SINGLE
    launch_range<0, ST_COUNT>(grid, a, stream);
#else
    launch_range<ST_PREP, ST_PREP + 1>(grid, a, stream);
    launch_range<ST_XN0, ST_XN0 + 1>(grid, a, stream);
    launch_range<ST_IN0, ST_IN0 + 1>(grid, a, stream);
    launch_range<ST_R2, ST_R2 + 1>(grid, a, stream);
    launch_range<ST_S5, ST_S5 + 1>(grid, a, stream);
    launch_range<ST_QUP, ST_QUP + 1>(grid, a, stream);
    launch_range<ST_KVUP, ST_KVUP + 1>(grid, a, stream);
    launch_range<ST_MLA, ST_MLA + 1>(grid, a, stream);
    launch_range<ST_GLU, ST_GLU + 1>(grid, a, stream);
    launch_range<ST_OUT0, ST_OUT0 + 1>(grid, a, stream);
    launch_range<ST_NORM0A, ST_NORM0A + 1>(grid, a, stream);
    launch_range<ST_GU0, ST_GU0 + 1>(grid, a, stream);
    launch_range<ST_DN0, ST_DN0 + 1>(grid, a, stream);
    launch_range<ST_NORM0B, ST_NORM0B + 1>(grid, a, stream);
    launch_range<ST_IN1, ST_IN1 + 1>(grid, a, stream);
    launch_range<ST_SB, ST_SB + 1>(grid, a, stream);
    launch_range<ST_LRU, ST_LRU + 1>(grid, a, stream);
    launch_range<ST_OUT1, ST_OUT1 + 1>(grid, a, stream);
    launch_range<ST_NORM1A, ST_NORM1A + 1>(grid, a, stream);
    launch_range<ST_GU1, ST_GU1 + 1>(grid, a, stream);
    launch_range<ST_DN1, ST_DN1 + 1>(grid, a, stream);
    launch_range<ST_NORM1B, ST_NORM1B + 1>(grid, a, stream);
#endif
}
```

```cpp
#include <hip/hip_runtime.h>
#include <cstdio>
#include <cstdint>

#ifndef MK_SINGLE
#define MK_SINGLE 1
#endif

#define LAS __attribute__((address_space(3)))
#define GAS __attribute__((address_space(1)))
typedef unsigned short bf16_t;
typedef short bf16x8 __attribute__((ext_vector_type(8)));
typedef short s16x4 __attribute__((ext_vector_type(4)));
typedef float f32x2 __attribute__((ext_vector_type(2)));
typedef float f32x4 __attribute__((ext_vector_type(4)));
typedef float f32x16 __attribute__((ext_vector_type(16)));
typedef unsigned u32x2 __attribute__((ext_vector_type(2)));
typedef unsigned u32x4 __attribute__((ext_vector_type(4)));
typedef __bf16 bf16x2_t __attribute__((ext_vector_type(2)));

constexpr int D = 1024, NB = 8, SEQ = 2048, M = NB * SEQ, FFH = 2816;
constexpr int IN0 = 1184, IN0P = 1280, IN1 = 2560;
constexpr float RMS_EPS = 1e-6f;
constexpr int NWAVES = 8, NTHR = 512;

constexpr size_t MiB = 1u << 20;
constexpr size_t WS_CTL = 0, CTL_ZERO_BYTES = 1 * MiB;
constexpr size_t WS_MODP = 1 * MiB;
constexpr size_t WS_MOD = 4 * MiB;
constexpr size_t WS_RS = 4 * MiB + 512 * 1024;
constexpr size_t WS_W = 6 * MiB;
constexpr size_t W_IN0 = WS_W;
constexpr size_t W_QUP = W_IN0 + (size_t)IN0P * D * 2;
constexpr size_t W_KVUP = W_QUP + (size_t)768 * 384 * 2;
constexpr size_t W_GLU = W_KVUP + (size_t)1024 * 256 * 2;
constexpr size_t W_OUT0 = W_GLU + (size_t)512 * 512 * 2;
constexpr size_t W_GU0 = W_OUT0 + (size_t)D * D * 2;
constexpr size_t W_DN0 = W_GU0 + (size_t)2 * FFH * D * 2;
constexpr size_t W_IN1 = W_DN0 + (size_t)D * FFH * 2;
constexpr size_t W_OUT1 = W_IN1 + (size_t)IN1 * D * 2;
constexpr size_t W_GU1 = W_OUT1 + (size_t)D * D * 2;
constexpr size_t W_DN1 = W_GU1 + (size_t)2 * FFH * D * 2;
constexpr size_t W_END = W_DN1 + (size_t)D * FFH * 2;
static_assert(W_END <= 54 * MiB, "weights region");
constexpr size_t WS_XN = 54 * MiB;
constexpr size_t WS_MIX = 86 * MiB;
constexpr size_t WS_PROJ0 = 118 * MiB;
constexpr size_t WS_Q = 158 * MiB;
constexpr size_t WS_K96 = 182 * MiB;
constexpr size_t WS_V = 206 * MiB;
constexpr size_t WS_Y = 222 * MiB;
constexpr size_t WS_PROJ1 = 118 * MiB;
constexpr size_t WS_FOUT = 118 * MiB;
constexpr size_t WS_FDN = 86 * MiB;
constexpr size_t WS_HID = 168 * MiB;
constexpr size_t WS_END = 256 * MiB;

constexpr int RING_BYTES = 131072;
constexpr int LDSCTL_OFF = RING_BYTES, MISC_OFF = LDSCTL_OFF + 320;
constexpr int LDS_BYTES = 147456;

#define LDS_WAIT() asm volatile("s_waitcnt lgkmcnt(0)" ::: "memory")
#define VM_WAIT() asm volatile("s_waitcnt vmcnt(0)" ::: "memory")
__device__ __forceinline__ unsigned cvtpk(float lo, float hi) { f32x2 v = {lo, hi}; bf16x2_t b = __builtin_convertvector(v, bf16x2_t); return __builtin_bit_cast(unsigned, b); }
__device__ __forceinline__ float bf2f(unsigned short b) { return __uint_as_float((unsigned)b << 16); }
__device__ __forceinline__ float bflo(unsigned w) { return __uint_as_float(w << 16); }
__device__ __forceinline__ float bfhi(unsigned w) { return __uint_as_float(w & 0xffff0000u); }
__device__ __forceinline__ float wave_sum(float v) {
#pragma unroll
    for (int o = 1; o < 64; o <<= 1) v += __shfl_xor(v, o);
    return v;
}
__device__ __forceinline__ float ex2(float x) { return __builtin_amdgcn_exp2f(x); }
__device__ __forceinline__ float lg2(float x) { return __builtin_amdgcn_logf(x); }
__device__ __forceinline__ float rcp(float x) { return __builtin_amdgcn_rcpf(x); }
constexpr float LOG2E = 1.4426950408889634f, LN2 = 0.6931471805599453f;
__device__ __forceinline__ float sigmoidf_(float x) { return rcp(1.0f + ex2(-x * LOG2E)); }
__device__ __forceinline__ float gelu_tanh(float x) { const float u = 0.7978845608028654f * (x + 0.044715f * x * x * x); return x * rcp(1.0f + ex2(-2.0f * LOG2E * u)); }
__device__ __forceinline__ int crow(int r, int hi) { return (r & 3) + 8 * (r >> 2) + 4 * hi; }
__device__ __forceinline__ float bsel(unsigned mask, float a, float b) { return __uint_as_float((__float_as_uint(a) & mask) | (__float_as_uint(b) & ~mask)); }

namespace pg8 {
constexpr int BM = 256, BK = 64, HALF = 128, HTB = HALF * BK * 2, STAGE_BYTES = 8 * HTB, NXCD = 8, WGM = 8;
__host__ __device__ __forceinline__ int lds_byte(int r, int c) { const int st = (r >> 4) * 2 + (c >> 5), rr = r & 15, cc = c & 31, ob = rr * 64 + cc * 2; return st * 1024 + (ob ^ (((ob >> 9) & 1) << 5)); }
__host__ __device__ __forceinline__ void stage_rc(int b, int& R, int& C) { const int st = b / 1024, sb = b % 1024, swz = sb ^ (((sb >> 9) & 1) << 5); R = (st >> 1) * 16 + swz / 64; C = (st & 1) * 32 + (swz % 64) / 2; }
__host__ __device__ __forceinline__ int perm32(int rho) { const int n = rho >> 4, i = rho & 15; return 8 * (i >> 2) + 4 * n + (i & 3); }
struct Unit { int pm, pn; };
struct Gemm { const bf16_t* A; const bf16_t* Bt; int M, N, K, lda; };
struct StaticOrder {
    int nM, nN, nwg, G, c;
    __device__ void init(int M_, int N_, int G_, int c_) { nM = M_ / BM; nN = N_ / BM; nwg = nM * nN; G = G_; c = c_; }
    __device__ bool next(int i, Unit& u) const {
        const long L = (long)i * G + c; if (L >= nwg) return false;
        int wgid = (int)L; { const int q = nwg / NXCD, r = nwg % NXCD, xcd = wgid % NXCD, off = wgid / NXCD; wgid = (xcd < r ? xcd * (q + 1) : r * (q + 1) + (xcd - r) * q) + off; }
        const int nig = WGM * nN, gid = wgid / nig, fm = gid * WGM, gsz = (nM - fm) < WGM ? (nM - fm) : WGM;
        u.pm = fm + ((wgid % nig) % gsz); u.pn = (wgid % nig) / gsz; return true;
    }
};

enum { EM_BF16 = 0, EM_KV = 1, EM_GLU = 2, EM_F32 = 3, EM_SWIGLU = 4 };
struct EpiP {
    int mode, perm;
    void* O; int ldc; void* O2;
    const float* rs;
    const float* bias;
    const bf16_t* Yin;
};
__device__ __forceinline__ void epi_run(const EpiP& E, const f32x4 (&acc)[2][2][4][2], const Unit& u, int wr, int wc, int fr, int fq) {
    const int row0 = u.pm * BM + wr * 64 + fr;
    if (E.mode == EM_F32) {
        const int col0 = u.pn * BM + wc * 32 + 4 * fq; float* C = (float*)E.O;
#pragma unroll
        for (int ai = 0; ai < 2; ++ai)
#pragma unroll
            for (int m = 0; m < 4; ++m) { float* rowp = C + (size_t)(row0 + ai * HALF + m * 16) * E.ldc + col0;
#pragma unroll
                for (int bj = 0; bj < 2; ++bj)
#pragma unroll
                    for (int n = 0; n < 2; ++n) *(f32x4*)(rowp + bj * HALF + n * 16) = acc[ai][bj][m][n]; }
    } else if (E.mode == EM_SWIGLU) {
        const int col0 = u.pn * HALF + wc * 32 + 8 * fq; bf16_t* O = (bf16_t*)E.O;
#pragma unroll
        for (int ai = 0; ai < 2; ++ai)
#pragma unroll
            for (int m = 0; m < 4; ++m) { bf16_t* rowp = O + (size_t)(row0 + ai * HALF + m * 16) * E.ldc + col0;
                float h[8];
#pragma unroll
                for (int n = 0; n < 2; ++n)
#pragma unroll
                    for (int i = 0; i < 4; ++i) { const float g = acc[ai][0][m][n][i], up = acc[ai][1][m][n][i]; h[4 * n + i] = g * sigmoidf_(g) * up; }
                u32x4 w; w.x = cvtpk(h[0], h[1]); w.y = cvtpk(h[2], h[3]); w.z = cvtpk(h[4], h[5]); w.w = cvtpk(h[6], h[7]);
                *(u32x4*)rowp = w; }
    } else {
#pragma unroll
        for (int ai = 0; ai < 2; ++ai)
#pragma unroll
            for (int m = 0; m < 4; ++m) { const int row = row0 + ai * HALF + m * 16; const float s = E.rs ? E.rs[row] : 1.0f;
#pragma unroll
                for (int bj = 0; bj < 2; ++bj) { const int col = u.pn * BM + bj * HALF + wc * 32 + 8 * fq;
                    f32x4 v0 = acc[ai][bj][m][0] * s, v1 = acc[ai][bj][m][1] * s;
                    bf16_t* dst;
                    if (E.mode == EM_BF16) dst = (bf16_t*)E.O + (size_t)row * E.ldc + col;
                    else if (E.mode == EM_KV) { const int head = col >> 7, w_ = col & 127;
                        dst = (w_ < 64) ? (bf16_t*)E.O + (size_t)row * 768 + head * 96 + w_ : (bf16_t*)E.O2 + (size_t)row * 512 + head * 64 + (w_ - 64); }
                    else {
                        const u32x4 yv = *(const u32x4*)(E.Yin + (size_t)row * 512 + col); const f32x4 b0 = *(const f32x4*)(E.bias + col), b1 = *(const f32x4*)(E.bias + col + 4);
                        v0[0] = bflo(yv.x) * sigmoidf_(v0[0] + b0[0]); v0[1] = bfhi(yv.x) * sigmoidf_(v0[1] + b0[1]); v0[2] = bflo(yv.y) * sigmoidf_(v0[2] + b0[2]); v0[3] = bfhi(yv.y) * sigmoidf_(v0[3] + b0[3]);
                        v1[0] = bflo(yv.z) * sigmoidf_(v1[0] + b1[0]); v1[1] = bfhi(yv.z) * sigmoidf_(v1[1] + b1[1]); v1[2] = bflo(yv.w) * sigmoidf_(v1[2] + b1[2]); v1[3] = bfhi(yv.w) * sigmoidf_(v1[3] + b1[3]);
                        dst = (bf16_t*)E.O + (size_t)row * E.ldc + 512 + col; }
                    u32x4 w; w.x = cvtpk(v0[0], v0[1]); w.y = cvtpk(v0[2], v0[3]); w.z = cvtpk(v1[0], v1[1]); w.w = cvtpk(v1[2], v1[3]);
                    *(u32x4*)dst = w; } }
    }
}

__device__ __forceinline__ void gemm_phase(LAS unsigned char* lds, const Gemm g, const StaticOrder& S, const EpiP& E) {
    const int tid = threadIdx.x, wid = __builtin_amdgcn_readfirstlane(tid >> 6), lane = tid & 63, wr = wid >> 2, wc = wid & 3, fr = lane & 15, fq = lane >> 4;
    const int K = g.K, nt = K / BK, lda = g.lda;
    unsigned voffA[2], voffB[2];
#pragma unroll
    for (int i = 0; i < 2; ++i) { int R, C; stage_rc(tid * 16 + i * 8192, R, C); const int Rb = E.perm ? ((R & ~31) + perm32(R & 31)) : R;
        voffA[i] = (unsigned)(R * lda + C) * 2u; voffB[i] = (unsigned)(Rb * K + C) * 2u; }
    const size_t kstep = (size_t)(BK * 2);
    const size_t hstepA = (size_t)HALF * lda * 2, hstepB = (size_t)HALF * K * 2;
    const size_t tstepA = 2 * hstepA, tstepB = 2 * hstepB;
    const unsigned ldsw = (unsigned)wid * 1024u;
    const int aoff = lds_byte(wr * 64 + fr, fq * 8), boff = lds_byte(wc * 32 + fr, fq * 8);
#define PG8_SA(b, h) (((b) * 2 + (h)) * HTB)
#define PG8_SB(b, h) ((4 + (b) * 2 + (h)) * HTB)
#define PG8_STAGE(bufoff, gbase, voff) do { _Pragma("unroll") for (int _i = 0; _i < 2; ++_i) \
        __builtin_amdgcn_global_load_lds((const unsigned*)((const char*)(gbase) + (voff)[_i]), (LAS unsigned*)(lds + (bufoff) + ldsw + _i * 8192), 16, 0, 0); } while (0)
#define PG8_LDA(dst, b, h) do { _Pragma("unroll") for (int m = 0; m < 4; ++m) _Pragma("unroll") for (int k = 0; k < 2; ++k) dst[m][k] = *(const LAS bf16x8*)(lds + PG8_SA(b, h) + aoff + m * 2048 + k * 1024); } while (0)
#define PG8_LDB(dst, b, h) do { _Pragma("unroll") for (int n = 0; n < 2; ++n) _Pragma("unroll") for (int k = 0; k < 2; ++k) dst[n][k] = *(const LAS bf16x8*)(lds + PG8_SB(b, h) + boff + n * 2048 + k * 1024); } while (0)
#define PG8_MMA(ai, bj, At, Bt) do { __builtin_amdgcn_s_setprio(1); _Pragma("unroll") for (int m = 0; m < 4; ++m) _Pragma("unroll") for (int n = 0; n < 2; ++n) _Pragma("unroll") for (int k = 0; k < 2; ++k) \
        acc[ai][bj][m][n] = __builtin_amdgcn_mfma_f32_16x16x32_bf16(Bt[n][k], At[m][k], acc[ai][bj][m][n], 0, 0, 0); __builtin_amdgcn_s_setprio(0); } while (0)
#define PG8_WAIT_V(n) asm volatile("s_waitcnt vmcnt(" #n ")" ::: "memory")
#define PG8_WAIT_L(n) asm volatile("s_waitcnt lgkmcnt(" #n ")" ::: "memory")
#define PG8_BAR __builtin_amdgcn_s_barrier()
#define PG8_SCHED __builtin_amdgcn_sched_barrier(0)
    Unit cur, nxt; int ui = 0;
    if (!S.next(0, cur)) return;
    f32x4 acc[2][2][4][2];
#pragma unroll
    for (int a = 0; a < 2; ++a)
#pragma unroll
        for (int b = 0; b < 2; ++b)
#pragma unroll
            for (int m = 0; m < 4; ++m)
#pragma unroll
                for (int n = 0; n < 2; ++n) acc[a][b][m][n] = (f32x4){0.f, 0.f, 0.f, 0.f};
    bf16x8 At[4][2], B0[2][2], B1[2][2];
    const char* cA = (const char*)g.A + (size_t)cur.pm * tstepA; const char* cB = (const char*)g.Bt + (size_t)cur.pn * tstepB;
    PG8_STAGE(PG8_SB(0, 0), cB, voffB); PG8_STAGE(PG8_SB(0, 1), cB + hstepB, voffB); PG8_STAGE(PG8_SA(0, 0), cA, voffA); PG8_STAGE(PG8_SA(0, 1), cA + hstepA, voffA);
    if (wr == 1) PG8_BAR;
    PG8_WAIT_V(2); PG8_BAR;
    PG8_STAGE(PG8_SB(1, 0), cB + kstep, voffB); PG8_STAGE(PG8_SA(1, 0), cA + kstep, voffA); PG8_STAGE(PG8_SB(1, 1), cB + hstepB + kstep, voffB);
    PG8_WAIT_V(6); PG8_BAR;
    for (;;) {
        const bool has_next = S.next(ui + 1, nxt);
        const char* nA = has_next ? (const char*)g.A + (size_t)nxt.pm * tstepA : cA; const char* nB = has_next ? (const char*)g.Bt + (size_t)nxt.pn * tstepB : cB;
        for (int t = 0; t < nt; t += 2) {
            const bool last = (t == nt - 2);
            const char* a1 = cA + (size_t)(t + 1) * kstep;
            const char* a2 = last ? nA : cA + (size_t)(t + 2) * kstep; const char* b2 = last ? nB : cB + (size_t)(t + 2) * kstep;
            const char* a3 = a2 + kstep; const char* b3 = b2 + kstep;
            PG8_LDB(B0, 0, 0); PG8_LDB(B1, 0, 1); PG8_SCHED; PG8_LDA(At, 0, 0); PG8_STAGE(PG8_SA(1, 1), a1 + hstepA, voffA);
            PG8_WAIT_V(8); PG8_WAIT_L(0); PG8_BAR; PG8_MMA(0, 0, At, B0); PG8_MMA(0, 1, At, B1); PG8_BAR; PG8_SCHED;
            PG8_LDA(At, 0, 1); PG8_STAGE(PG8_SB(0, 0), b2, voffB); PG8_STAGE(PG8_SB(0, 1), b2 + hstepB, voffB); PG8_STAGE(PG8_SA(0, 0), a2, voffA);
            PG8_WAIT_V(8); PG8_WAIT_L(0); PG8_BAR; PG8_MMA(1, 0, At, B0); PG8_MMA(1, 1, At, B1); PG8_BAR; PG8_SCHED;
            PG8_LDB(B0, 1, 0); PG8_LDB(B1, 1, 1); PG8_SCHED; PG8_LDA(At, 1, 0); PG8_STAGE(PG8_SA(0, 1), a2 + hstepA, voffA);
            PG8_WAIT_V(8); PG8_WAIT_L(0); PG8_BAR; PG8_MMA(0, 0, At, B0); PG8_MMA(0, 1, At, B1); PG8_BAR; PG8_SCHED;
            PG8_LDA(At, 1, 1); PG8_STAGE(PG8_SB(1, 0), b3, voffB); PG8_STAGE(PG8_SB(1, 1), b3 + hstepB, voffB); PG8_STAGE(PG8_SA(1, 0), a3, voffA);
            PG8_WAIT_V(8); PG8_WAIT_L(0); PG8_BAR; PG8_MMA(1, 0, At, B0); PG8_MMA(1, 1, At, B1); PG8_BAR; PG8_SCHED;
        }
        if (wr == 0) PG8_BAR;
        epi_run(E, acc, cur, wr, wc, fr, fq);
        if (!has_next) break;
#pragma unroll
        for (int a = 0; a < 2; ++a)
#pragma unroll
            for (int b = 0; b < 2; ++b)
#pragma unroll
                for (int m = 0; m < 4; ++m)
#pragma unroll
                    for (int n = 0; n < 2; ++n) acc[a][b][m][n] = (f32x4){0.f, 0.f, 0.f, 0.f};
        cur = nxt; cA = nA; cB = nB; ++ui;
        if (wr == 1) PG8_BAR;
    }
    PG8_WAIT_V(0);
    PG8_BAR;
#undef PG8_SA
#undef PG8_SB
#undef PG8_STAGE
#undef PG8_LDA
#undef PG8_LDB
#undef PG8_MMA
#undef PG8_WAIT_V
#undef PG8_WAIT_L
#undef PG8_BAR
#undef PG8_SCHED
}
}

typedef GAS unsigned gu32;
#define RLX_AGENT __ATOMIC_RELAXED, __HIP_MEMORY_SCOPE_AGENT
#define XB_TMO      128
#define XB_XCNT(j)  (256  + 64 * (j))
#define XB_XSUB(j)  (1280 + 64 * (j))
#define XB_XGEN(j)  (2304 + 64 * (j))
#define XB_TOP      3328
#define XB_TOPGEN   3392
#define XCD_BAR_WORDS 3456
#define XB_SPIN_CAP (1u << 18)
__device__ __forceinline__ unsigned xb_ld(unsigned* p)              { return __hip_atomic_load(p, __ATOMIC_RELAXED, __HIP_MEMORY_SCOPE_AGENT); }
__device__ __forceinline__ unsigned xb_add(unsigned* p, unsigned v) { return __hip_atomic_fetch_add(p, v, __ATOMIC_RELAXED, __HIP_MEMORY_SCOPE_AGENT); }
__device__ __forceinline__ unsigned xb_xcc_id() { return (unsigned)__builtin_amdgcn_s_getreg((3 << 11) | 20) & 0xFu; }
#define XB_SPIN(cond, bar) do { unsigned _sp = 0; while (cond) { __builtin_amdgcn_s_sleep(1); \
    if ((++_sp & 255u) == 0u) { if (xb_ld(&(bar)[XB_TMO])) break; if (_sp > XB_SPIN_CAP) { atomicAdd(&(bar)[XB_TMO], 1u); break; } } } } while (0)
struct XcdBarrier { unsigned* bar; unsigned x; volatile LAS unsigned* st; };
__device__ __forceinline__ XcdBarrier xcd_barrier_post(unsigned* bar, volatile LAS unsigned* st) {
    XcdBarrier b; b.bar = bar; b.x = xb_xcc_id(); b.st = st;
    if (threadIdx.x == 0) (void)xb_add(&bar[XB_XCNT(b.x)], 1u);
    return b;
}
__device__ __forceinline__ void xcd_barrier_complete(unsigned* bar, unsigned x, unsigned& nloc, unsigned& nx) {
    const unsigned G = gridDim.x * gridDim.y * gridDim.z;
    unsigned sum, cnt, mine, sp = 0u;
    for (;;) {
        sum = 0u; cnt = 0u; mine = 0u;
#pragma unroll
        for (unsigned j = 0; j < 16; ++j) { const unsigned c = xb_ld(&bar[XB_XCNT(j)]); sum += c; cnt += (c > 0u) ? 1u : 0u; mine = (j == x) ? c : mine; }
        if (sum == G) break;
        __builtin_amdgcn_s_sleep(1);
        if ((++sp & 255u) == 0u) { if (xb_ld(&bar[XB_TMO])) break; if (sp > XB_SPIN_CAP) { atomicAdd(&bar[XB_TMO], 1u); break; } }
    }
    nloc = mine > 0u ? mine : 1u; nx = cnt > 0u ? cnt : 1u;
}
__device__ __forceinline__ void xcd_barrier(const XcdBarrier& b) {
    asm volatile("s_waitcnt vmcnt(0)" ::: "memory");
    __syncthreads();
    if (threadIdx.x == 0) {
        unsigned* bar = b.bar;
        __builtin_amdgcn_s_waitcnt(0);
        unsigned nloc = b.st[0], nx = b.st[1];
        if (nloc == 0u) { xcd_barrier_complete(bar, b.x, nloc, nx); b.st[0] = nloc; b.st[1] = nx; }
        const unsigned old = xb_add(&bar[XB_XSUB(b.x)], 1u);
        const unsigned gen = old / nloc;
        if (old + 1u == (gen + 1u) * nloc) {
            __builtin_amdgcn_fence(__ATOMIC_RELEASE, "agent");
            asm volatile("s_waitcnt vmcnt(0)" ::: "memory");
            const unsigned og = xb_add(&bar[XB_TOP], 1u);
            const unsigned tg = og / nx;
            if (og + 1u == (tg + 1u) * nx) xb_add(&bar[XB_TOPGEN], 1u);
            else XB_SPIN(xb_ld(&bar[XB_TOPGEN]) == tg, bar);
            __builtin_amdgcn_fence(__ATOMIC_ACQUIRE, "agent");
            xb_add(&bar[XB_XGEN(b.x)], 1u);
            asm volatile("s_waitcnt vmcnt(0)" ::: "memory");
        } else {
            XB_SPIN(xb_ld(&bar[XB_XGEN(b.x)]) == gen, bar);
            __builtin_amdgcn_fence(__ATOMIC_ACQUIRE, "agent");
            asm volatile("s_waitcnt vmcnt(0)" ::: "memory");
        }
    }
    __syncthreads();
}

struct Args { const void* in[33]; float* out; unsigned char* ws; };
struct Frame {
    LAS unsigned char* lds;
    int tid, lane, wave, G, bid;
    const Args* a;
    unsigned char* ws;
};
#define INF(i) ((const float*)F.a->in[i])

__device__ __forceinline__ void transpose_item(const float* W, int K, int N, bf16_t* WT, int mapmode, int row_off, const float* kscale, LAS float* scr, int item, int lane) {
    const int nblk = N / 32, kb = item / nblk, nb = item % nblk, k0 = 64 * kb, n0 = 32 * nb;
#pragma unroll 8
    for (int i = 0; i < 32; ++i) { const int kk = 2 * i + (lane >> 5); scr[kk * 33 + (lane & 31)] = W[(size_t)(k0 + kk) * N + n0 + (lane & 31)]; }
    LDS_WAIT(); asm volatile("" ::: "memory");
    const int c = lane & 7;
    float sc[8];
#pragma unroll
    for (int i = 0; i < 8; ++i) sc[i] = kscale ? kscale[k0 + 8 * c + i] : 1.0f;
#pragma unroll
    for (int j = 0; j < 4; ++j) { const int n = (lane >> 3) + 8 * j; const LAS float* s = scr + (8 * c) * 33 + n;
        u32x4 o; o.x = cvtpk(s[0 * 33] * sc[0], s[1 * 33] * sc[1]); o.y = cvtpk(s[2 * 33] * sc[2], s[3 * 33] * sc[3]); o.z = cvtpk(s[4 * 33] * sc[4], s[5 * 33] * sc[5]); o.w = cvtpk(s[6 * 33] * sc[6], s[7 * 33] * sc[7]);
        const int nn = n0 + n; const int drow = mapmode ? ((nn >> 7) * 256 + (nn & 127) + row_off) : (nn + row_off);
        *(u32x4*)(WT + (size_t)drow * K + k0 + 8 * c) = o; }
    LDS_WAIT(); asm volatile("" ::: "memory");
}
__device__ __forceinline__ void modp_item(Frame& F, LAS float* cact, int item) {
    const int cg = item >> 3, ks = item & 7, l = cg / 96, j = (cg % 96) * 64 + F.lane;
    const float* c = INF(1);
#pragma unroll
    for (int i = 0; i < 16; ++i) { const int idx = F.lane + 64 * i, b = idx >> 7, kk = idx & 127; const float v = c[b * 1024 + ks * 128 + kk]; cact[idx] = v * sigmoidf_(v); }
    LDS_WAIT(); asm volatile("" ::: "memory");
    float acc[8];
#pragma unroll
    for (int b = 0; b < 8; ++b) acc[b] = 0.f;
    const float* w = INF(3) + ((size_t)l * 1024 + ks * 128) * 6144 + j;
#pragma unroll 8
    for (int kk = 0; kk < 128; ++kk) { const float wv = w[(size_t)kk * 6144];
#pragma unroll
        for (int b = 0; b < 8; ++b) acc[b] += cact[b * 128 + kk] * wv; }
    float* modp = (float*)(F.ws + WS_MODP);
    const float bias = (ks == 0) ? INF(4)[l * 6144 + j] : 0.f;
#pragma unroll
    for (int b = 0; b < 8; ++b) modp[((size_t)(ks * 2 + l) * 8 + b) * 6144 + j] = acc[b] + bias;
    LDS_WAIT(); asm volatile("" ::: "memory");
}
__device__ __forceinline__ void step_prep(Frame& F) {
    LAS float* scr = (LAS float*)(F.lds + F.wave * 16384);
    LAS float* cact = scr + 64 * 33;
    const int gw = F.bid * NWAVES + F.wave, NGW = F.G * NWAVES;
    constexpr int N_MODP = 192 * 8;
    constexpr int I_IN0 = 16 * 37, I_QUP = 6 * 24, I_KVUP = 4 * 32, I_GLU = 8 * 16, I_OUT = 16 * 32, I_G = 16 * 88, I_DN = 44 * 32, I_IN1 = 16 * 80;
    constexpr int NITEMS = N_MODP + I_IN0 + I_QUP + I_KVUP + I_GLU + 2 * I_OUT + 4 * I_G + 2 * I_DN + I_IN1;
    unsigned char* ws = F.ws;
    for (int it = gw; it < NITEMS; it += NGW) {
        int r = it;
        if (r < N_MODP) { modp_item(F, cact, r); continue; } r -= N_MODP;
        if (r < I_IN0) { transpose_item(INF(10), 1024, IN0, (bf16_t*)(ws + W_IN0), 0, 0, nullptr, scr, r, F.lane); continue; } r -= I_IN0;
        if (r < I_QUP) { transpose_item(INF(13), 384, 768, (bf16_t*)(ws + W_QUP), 0, 0, INF(11), scr, r, F.lane); continue; } r -= I_QUP;
        if (r < I_KVUP) { transpose_item(INF(14), 256, 1024, (bf16_t*)(ws + W_KVUP), 0, 0, INF(12), scr, r, F.lane); continue; } r -= I_KVUP;
        if (r < I_GLU) { transpose_item(INF(23), 512, 512, (bf16_t*)(ws + W_GLU), 0, 0, nullptr, scr, r, F.lane); continue; } r -= I_GLU;
        if (r < I_OUT) { transpose_item(INF(6), 1024, 1024, (bf16_t*)(ws + W_OUT0), 0, 0, nullptr, scr, r, F.lane); continue; } r -= I_OUT;
        if (r < I_OUT) { transpose_item(INF(6) + (size_t)D * D, 1024, 1024, (bf16_t*)(ws + W_OUT1), 0, 0, nullptr, scr, r, F.lane); continue; } r -= I_OUT;
        if (r < I_G) { transpose_item(INF(7), 1024, FFH, (bf16_t*)(ws + W_GU0), 1, 0, nullptr, scr, r, F.lane); continue; } r -= I_G;
        if (r < I_G) { transpose_item(INF(8), 1024, FFH, (bf16_t*)(ws + W_GU0), 1, 128, nullptr, scr, r, F.lane); continue; } r -= I_G;
        if (r < I_G) { transpose_item(INF(7) + (size_t)D * FFH, 1024, FFH, (bf16_t*)(ws + W_GU1), 1, 0, nullptr, scr, r, F.lane); continue; } r -= I_G;
        if (r < I_G) { transpose_item(INF(8) + (size_t)D * FFH, 1024, FFH, (bf16_t*)(ws + W_GU1), 1, 128, nullptr, scr, r, F.lane); continue; } r -= I_G;
        if (r < I_DN) { transpose_item(INF(9), FFH, 1024, (bf16_t*)(ws + W_DN0), 0, 0, nullptr, scr, r, F.lane); continue; } r -= I_DN;
        if (r < I_DN) { transpose_item(INF(9) + (size_t)FFH * D, FFH, 1024, (bf16_t*)(ws + W_DN1), 0, 0, nullptr, scr, r, F.lane); continue; } r -= I_DN;
        transpose_item(INF(25), 1024, IN1, (bf16_t*)(ws + W_IN1), 0, 0, nullptr, scr, r, F.lane);
    }
    { u32x4* p = (u32x4*)(ws + W_IN0 + (size_t)IN0 * D * 2); const int n16 = (IN0P - IN0) * D * 2 / 16;
      for (int i = F.bid * NTHR + F.tid; i < n16; i += F.G * NTHR) p[i] = (u32x4){0u, 0u, 0u, 0u}; }
}

__device__ __forceinline__ float row_sumsq(const f32x4 (&v)[4]) {
    float s = 0.f;
#pragma unroll
    for (int j = 0; j < 4; ++j) s += (v[j].x * v[j].x + v[j].y * v[j].y) + (v[j].z * v[j].z + v[j].w * v[j].w);
    return wave_sum(s);
}

__device__ __forceinline__ void step_xn0(Frame& F) {
    const float* modp = (const float*)(F.ws + WS_MODP);
    float* mod = (float*)(F.ws + WS_MOD);
    { const int e = F.bid * 384 + F.tid;
      if (F.tid < 384 && e < 98304) { float s = 0.f;
#pragma unroll
          for (int ks = 0; ks < 8; ++ks) s += modp[(size_t)ks * 98304 + e];
          mod[e] = s; } }
    LAS float* shv = (LAS float*)F.lds; LAS float* scv = shv + 1024;
    for (int rb = F.bid; rb < M / 64; rb += F.G) {
        const int b = (rb * 64) / SEQ;
        __syncthreads();
        for (int col = F.tid; col < 1024; col += NTHR) { float s0 = 0.f, s1 = 0.f;
#pragma unroll
            for (int ks = 0; ks < 8; ++ks) { const float* p = modp + ((size_t)(ks * 2 + 0) * 8 + b) * 6144; s0 += p[col]; s1 += p[1024 + col]; }
            shv[col] = s0; scv[col] = s1; }
        __syncthreads();
        const float* g0 = INF(5);
        for (int i = 0; i < 8; ++i) {
            const int row = rb * 64 + F.wave * 8 + i;
            const f32x4* xr = (const f32x4*)(INF(0) + (size_t)row * D) + F.lane;
            f32x4 v[4];
#pragma unroll
            for (int j = 0; j < 4; ++j) v[j] = xr[64 * j];
            const float rs = 1.0f / sqrtf(row_sumsq(v) * (1.0f / D) + RMS_EPS);
            u32x2* o = (u32x2*)((bf16_t*)(F.ws + WS_XN) + (size_t)row * D) + F.lane;
#pragma unroll
            for (int j = 0; j < 4; ++j) { const int col = 4 * F.lane + 256 * j; const f32x4 gg = *(const f32x4*)(g0 + col);
                float t[4];
#pragma unroll
                for (int k = 0; k < 4; ++k) t[k] = v[j][k] * rs * gg[k] * (1.0f + scv[col + k]) + shv[col + k];
                u32x2 w; w.x = cvtpk(t[0], t[1]); w.y = cvtpk(t[2], t[3]); o[64 * j] = w; }
        }
    }
}

__device__ __forceinline__ void step_norm(Frame& F, const float* Fin, const float* base, const float* gpost, int gate_off, int layer,
                                          bool has_next, const float* gpre, int nlayer, int sh_off, int sc_off) {
    const float* mod = (const float*)(F.ws + WS_MOD);
    const int gw = F.bid * NWAVES + F.wave, NGW = F.G * NWAVES;
    for (int row = gw; row < M; row += NGW) {
        const int b = row / SEQ;
        const f32x4* fr = (const f32x4*)(Fin + (size_t)row * D) + F.lane;
        const f32x4* br = (const f32x4*)(base + (size_t)row * D) + F.lane;
        f32x4 v[4], h[4];
#pragma unroll
        for (int j = 0; j < 4; ++j) { v[j] = fr[64 * j]; h[j] = br[64 * j]; }
        const float rs = 1.0f / sqrtf(row_sumsq(v) * (1.0f / D) + RMS_EPS);
        const float* gt = mod + ((size_t)layer * 8 + b) * 6144 + gate_off;
#pragma unroll
        for (int j = 0; j < 4; ++j) { const int col = 4 * F.lane + 256 * j; const f32x4 gp = *(const f32x4*)(gpost + col), ga = *(const f32x4*)(gt + col);
            h[j] = h[j] + ga * (v[j] * rs * gp); }
        f32x4* orow = (f32x4*)(F.a->out + (size_t)row * D) + F.lane;
#pragma unroll
        for (int j = 0; j < 4; ++j) orow[64 * j] = h[j];
        if (has_next) {
            const float rs2 = 1.0f / sqrtf(row_sumsq(h) * (1.0f / D) + RMS_EPS);
            const float* mn = mod + ((size_t)nlayer * 8 + b) * 6144;
            u32x2* o = (u32x2*)((bf16_t*)(F.ws + WS_XN) + (size_t)row * D) + F.lane;
#pragma unroll
            for (int j = 0; j < 4; ++j) { const int col = 4 * F.lane + 256 * j; const f32x4 gg = *(const f32x4*)(gpre + col), sh = *(const f32x4*)(mn + sh_off + col), sc = *(const f32x4*)(mn + sc_off + col);
                const f32x4 t = h[j] * rs2 * gg * (sc + 1.0f) + sh;
                u32x2 w; w.x = cvtpk(t[0], t[1]); w.y = cvtpk(t[2], t[3]); o[64 * j] = w; }
        }
    }
}

__device__ __forceinline__ void step_r2(Frame& F) {
    const bf16_t* proj = (const bf16_t*)(F.ws + WS_PROJ0);
    float* rsq = (float*)(F.ws + WS_RS); float* rskv = rsq + M;
    bf16_t* k96 = (bf16_t*)(F.ws + WS_K96);
    const int* pos = (const int*)F.a->in[2];
    const int gw = F.bid * NWAVES + F.wave, NGW = F.G * NWAVES;
    for (int row = gw; row < M; row += NGW) {
        const bf16_t* p = proj + (size_t)row * IN0P;
        const unsigned* pq = (const unsigned*)(p + 6 * F.lane);
        float sq = 0.f;
#pragma unroll
        for (int i = 0; i < 3; ++i) { const unsigned w = pq[i]; const float a = bflo(w), b = bfhi(w); sq += a * a + b * b; }
        const u32x2 wk = *(const u32x2*)(p + 384 + 4 * F.lane);
        float sk = bflo(wk.x) * bflo(wk.x) + bfhi(wk.x) * bfhi(wk.x) + bflo(wk.y) * bflo(wk.y) + bfhi(wk.y) * bfhi(wk.y);
        sq = wave_sum(sq); sk = wave_sum(sk);
        if (F.lane == 0) { rsq[row] = 1.0f / sqrtf(sq * (1.0f / 384.0f) + RMS_EPS); rskv[row] = 1.0f / sqrtf(sk * (1.0f / 256.0f) + RMS_EPS); }
        const float x = bf2f(p[640 + (F.lane & 31)]);
        const float other = __shfl_xor(x, 16);
        const int i = F.lane & 15;
        const float inv = exp2f(-(float)i * (13.287712379549449f / 16.0f));
        const float ang = (float)pos[row] * inv;
        float sn, cs; sincosf(ang, &sn, &cs);
        const float o = (F.lane & 16) ? (x * cs + other * sn) : (x * cs - other * sn);
        const unsigned short ob = (unsigned short)(cvtpk(o, o) & 0xffffu);
        if (F.lane < 32) {
#pragma unroll
            for (int h = 0; h < 8; ++h) k96[(size_t)row * 768 + h * 96 + 64 + F.lane] = ob;
        }
    }
}

template <int DK, int MODE>
__device__ __forceinline__ void attn_unit(LAS unsigned char* lds, const bf16_t* Q, int ldq, const bf16_t* K, int ldk, const bf16_t* V, int ldv, bf16_t* O, int ldo,
                                          int b, int qb, const int* pos, int tid) {
    constexpr int NS = DK / 16, KS = DK * 2 + 16, KCH = DK / 8;
    const int lane = tid & 63, r32 = lane & 31, hi = lane >> 5; const int wid = __builtin_amdgcn_readfirstlane(tid >> 6);
    const int rowbase = b * SEQ, q0 = qb * 256, qrow = q0 + wid * 32 + r32;
    LAS unsigned char* Ks = lds; LAS unsigned char* Vs = lds + 16384;
    bf16x8 qf[NS];
    { const bf16_t* qp = Q + (size_t)(rowbase + qrow) * ldq + 8 * hi;
#pragma unroll
      for (int s = 0; s < NS; ++s) qf[s] = *(const bf16x8*)(qp + 16 * s); }
    if (MODE == 0) {
        const float p = (float)pos[rowbase + qrow];
#pragma unroll
        for (int j = 0; j < 8; ++j) { const int i = 8 * hi + j; const float inv = exp2f(-(float)i * (13.287712379549449f / 16.0f));
            float sn, cs; sincosf(p * inv, &sn, &cs);
            const float x1 = bf2f((unsigned short)qf[NS - 2][j]), x2 = bf2f((unsigned short)qf[NS - 1][j]);
            const unsigned w = cvtpk(x1 * cs - x2 * sn, x2 * cs + x1 * sn);
            qf[NS - 2][j] = (short)(w & 0xffffu); qf[NS - 1][j] = (short)(w >> 16); }
    }
    f32x16 o0, o1;
#pragma unroll
    for (int r = 0; r < 16; ++r) { o0[r] = 0.f; o1[r] = 0.f; }
    float mrun = -INFINITY, lrun = 0.f, R = 0.f;
    const int NT = (q0 + 256) / 64;
    const int vaddr = ((lane >> 4) & 1) * 32 + (lane & 3) * 8 + (4 * hi + ((lane & 15) >> 2)) * 64;
    for (int it = 0; it < NT; ++it) {
        const int kt = (MODE == 0) ? it : (NT - 1 - it), k0 = kt * 64;
        __syncthreads();
        for (int c = tid; c < 64 * KCH; c += NTHR) { const int key = c / KCH, part = c % KCH;
            const u32x4 v = *(const u32x4*)(K + (size_t)(rowbase + k0 + key) * ldk + 8 * part); *(LAS u32x4*)(Ks + key * KS + 16 * part) = v; }
        { const int key = tid >> 3, dch = tid & 7; const u32x4 v = *(const u32x4*)(V + (size_t)(rowbase + k0 + key) * ldv + 8 * dch);
          *(LAS u32x4*)(Vs + (dch >> 2) * 4096 + key * 64 + (dch & 3) * 16) = v; }
        __syncthreads();
        if (k0 > q0 + wid * 32 + 31) continue;
        f32x16 p0, p1;
#pragma unroll
        for (int r = 0; r < 16; ++r) { p0[r] = 0.f; p1[r] = 0.f; }
#pragma unroll
        for (int s = 0; s < NS; ++s) { const bf16x8 a0 = *(const LAS bf16x8*)(Ks + r32 * KS + 32 * s + 16 * hi), a1 = *(const LAS bf16x8*)(Ks + (32 + r32) * KS + 32 * s + 16 * hi);
            p0 = __builtin_amdgcn_mfma_f32_32x32x16_bf16(a0, qf[s], p0, 0, 0, 0); p1 = __builtin_amdgcn_mfma_f32_32x32x16_bf16(a1, qf[s], p1, 0, 0, 0); }
        if (MODE == 0) {
            const float c2 = 0.10206207261596577f * LOG2E;
            float rm = -INFINITY;
#pragma unroll
            for (int r = 0; r < 16; ++r) { const int key = k0 + crow(r, hi);
                p0[r] = (key > qrow) ? -INFINITY : p0[r] * c2; p1[r] = (key + 32 > qrow) ? -INFINITY : p1[r] * c2;
                rm = fmaxf(rm, fmaxf(p0[r], p1[r])); }
            rm = fmaxf(rm, __shfl_xor(rm, 32));
            const float mn = fmaxf(mrun, rm), alpha = ex2(mrun - mn);
            float ls = 0.f;
#pragma unroll
            for (int r = 0; r < 16; ++r) { p0[r] = ex2(p0[r] - mn); p1[r] = ex2(p1[r] - mn); ls += p0[r] + p1[r]; }
            lrun = lrun * alpha + ls; mrun = mn;
#pragma unroll
            for (int r = 0; r < 16; ++r) { o0[r] *= alpha; o1[r] *= alpha; }
        } else {
            float lb0[16], lb1[16];
#pragma unroll
            for (int r = 0; r < 16; ++r) { const int key = k0 + crow(r, hi);
                { const float z = p0[r] * 0.125f; const float sp = lg2(1.0f + ex2(-fabsf(z) * LOG2E)) * LN2; const float lb = fminf(z, 0.f) - sp; lb0[r] = lb; p0[r] = (key >= qrow) ? 0.f : (lb - z); }
                { const float z = p1[r] * 0.125f; const float sp = lg2(1.0f + ex2(-fabsf(z) * LOG2E)) * LN2; const float lb = fminf(z, 0.f) - sp; lb1[r] = lb; p1[r] = (key + 32 >= qrow) ? 0.f : (lb - z); } }
            float T[16]; const unsigned him = (unsigned)(-hi);
#pragma unroll
            for (int a = 0; a < 4; ++a) { const float g0 = (p0[4 * a] + p0[4 * a + 1]) + (p0[4 * a + 2] + p0[4 * a + 3]), g1 = (p1[4 * a] + p1[4 * a + 1]) + (p1[4 * a + 2] + p1[4 * a + 3]);
                const float q0_ = __shfl_xor(g0, 32), q1_ = __shfl_xor(g1, 32);
                T[2 * a] = bsel(him, q0_, g0); T[2 * a + 1] = bsel(him, g0, q0_); T[8 + 2 * a] = bsel(him, q1_, g1); T[8 + 2 * a + 1] = bsel(him, g1, q1_); }
            float suf[16]; suf[15] = 0.f;
#pragma unroll
            for (int i = 14; i >= 0; --i) suf[i] = suf[i + 1] + T[i + 1];
            const float total = suf[0] + T[0];
#pragma unroll
            for (int a = 0; a < 4; ++a) {
                { float s = R + bsel(him, suf[2 * a + 1], suf[2 * a]);
#pragma unroll
                  for (int i = 3; i >= 0; --i) { const int r = 4 * a + i; const int key = k0 + crow(r, hi); const float l1 = p0[r]; p0[r] = (key >= qrow) ? 0.f : ex2((lb0[r] + s) * LOG2E); s += l1; } }
                { float s = R + bsel(him, suf[8 + 2 * a + 1], suf[8 + 2 * a]);
#pragma unroll
                  for (int i = 3; i >= 0; --i) { const int r = 4 * a + i; const int key = k0 + 32 + crow(r, hi); const float l1 = p1[r]; p1[r] = (key >= qrow) ? 0.f : ex2((lb1[r] + s) * LOG2E); s += l1; } }
            }
            R += total;
        }
        bf16x8 pa[4];
        { u32x4 w;
          w.x = cvtpk(p0[0], p0[1]); w.y = cvtpk(p0[2], p0[3]); w.z = cvtpk(p0[4], p0[5]); w.w = cvtpk(p0[6], p0[7]); pa[0] = __builtin_bit_cast(bf16x8, w);
          w.x = cvtpk(p0[8], p0[9]); w.y = cvtpk(p0[10], p0[11]); w.z = cvtpk(p0[12], p0[13]); w.w = cvtpk(p0[14], p0[15]); pa[1] = __builtin_bit_cast(bf16x8, w);
          w.x = cvtpk(p1[0], p1[1]); w.y = cvtpk(p1[2], p1[3]); w.z = cvtpk(p1[4], p1[5]); w.w = cvtpk(p1[6], p1[7]); pa[2] = __builtin_bit_cast(bf16x8, w);
          w.x = cvtpk(p1[8], p1[9]); w.y = cvtpk(p1[10], p1[11]); w.z = cvtpk(p1[12], p1[13]); w.w = cvtpk(p1[14], p1[15]); pa[3] = __builtin_bit_cast(bf16x8, w); }
#pragma unroll
        for (int dt = 0; dt < 2; ++dt)
#pragma unroll
            for (int s = 0; s < 4; ++s) {
                const LAS unsigned char* vp = Vs + dt * 4096 + s * 1024 + vaddr;
                const s16x4 lo = __builtin_bit_cast(s16x4, __builtin_amdgcn_ds_read_tr16_b64_v4i16((LAS s16x4*)vp));
                const s16x4 hh = __builtin_bit_cast(s16x4, __builtin_amdgcn_ds_read_tr16_b64_v4i16((LAS s16x4*)(vp + 512)));
                const bf16x8 vf = (bf16x8){lo[0], lo[1], lo[2], lo[3], hh[0], hh[1], hh[2], hh[3]};
                if (dt == 0) o0 = __builtin_amdgcn_mfma_f32_32x32x16_bf16(vf, pa[s], o0, 0, 0, 0);
                else o1 = __builtin_amdgcn_mfma_f32_32x32x16_bf16(vf, pa[s], o1, 0, 0, 0);
            }
    }
    float inv = 1.0f;
    if (MODE == 0) { const float lt = lrun + __shfl_xor(lrun, 32); inv = 1.0f / lt; }
    bf16_t* op = O + (size_t)(rowbase + qrow) * ldo;
#pragma unroll
    for (int rg = 0; rg < 4; ++rg) {
        u32x2 w0, w1;
        w0.x = cvtpk(o0[4 * rg] * inv, o0[4 * rg + 1] * inv); w0.y = cvtpk(o0[4 * rg + 2] * inv, o0[4 * rg + 3] * inv);
        w1.x = cvtpk(o1[4 * rg] * inv, o1[4 * rg + 1] * inv); w1.y = cvtpk(o1[4 * rg + 2] * inv, o1[4 * rg + 3] * inv);
        *(u32x2*)(op + 8 * rg + 4 * hi) = w0; *(u32x2*)(op + 32 + 8 * rg + 4 * hi) = w1;
    }
}

__device__ __forceinline__ void s5_unit(Frame& F, int b, int g) {
    const int tid = F.tid, p = tid & 63, sub = __builtin_amdgcn_readfirstlane(tid >> 6);
    LAS float* us = (LAS float*)F.lds;
    LAS float* E = us + 2048;
    LAS float* Hre = E + 1024;
    LAS float* Him = Hre + 128 * 65;
    LAS float* Cre = Him + 128 * 65;
    LAS float* Cim = Cre + 1024;
    LAS float* Dsk = Cim + 1024;
    __syncthreads();
    for (int i = tid; i < 1024; i += NTHR) { const int c = i >> 6, pp = i & 63; Cre[pp * 16 + c] = INF(20)[(g * 16 + c) * 64 + pp]; Cim[pp * 16 + c] = INF(21)[(g * 16 + c) * 64 + pp]; }
    if (tid < 16) Dsk[tid] = INF(22)[g * 16 + tid];
    const float lre = fminf(INF(15)[g * 64 + p], -1e-4f), lim = INF(16)[g * 64 + p], dt = expf(INF(17)[g]);
    const float mag = expf(lre * dt); float sn, cs; sincosf(lim * dt, &sn, &cs);
    const float lbr = mag * cs, lbi = mag * sn;
    const float sh = sinf(0.5f * lim * dt);
    const float nr = expm1f(lre * dt) * cs - 2.0f * sh * sh, ni = lbi;
    const float den = 1.0f / (lre * lre + lim * lim);
    const float fr = (nr * lre + ni * lim) * den, fi = (ni * lre - nr * lim) * den;
    float bbr[16], bbi[16];
#pragma unroll
    for (int c = 0; c < 16; ++c) { const float br = INF(18)[(g * 64 + p) * 16 + c], bi = INF(19)[(g * 64 + p) * 16 + c]; bbr[c] = fr * br - fi * bi; bbi[c] = fr * bi + fi * br; }
    float l16r = lbr, l16i = lbi;
#pragma unroll
    for (int i = 0; i < 4; ++i) { const float r = l16r * l16r - l16i * l16i, im = 2.0f * l16r * l16i; l16r = r; l16i = im; }
    float cr = 0.f, ci = 0.f;
    const bf16_t* proj = (const bf16_t*)(F.ws + WS_PROJ0);
    bf16_t* Y = (bf16_t*)(F.ws + WS_Y);
    const int rowbase = b * SEQ;
    for (int seg = 0; seg < SEQ / 128; ++seg) {
        const int t_ld = tid >> 2, c4 = (tid & 3) * 4;
        { const u32x2 w = *(const u32x2*)(proj + (size_t)(rowbase + seg * 128 + t_ld) * IN0P + 672 + g * 16 + c4);
          us[t_ld * 16 + c4] = bflo(w.x); us[t_ld * 16 + c4 + 1] = bfhi(w.x); us[t_ld * 16 + c4 + 2] = bflo(w.y); us[t_ld * 16 + c4 + 3] = bfhi(w.y); }
        __syncthreads();
        float bur[16], bui[16]; float er = 0.f, ei = 0.f;
#pragma unroll
        for (int j = 0; j < 16; ++j) { float ur = 0.f, ui = 0.f;
#pragma unroll
            for (int c = 0; c < 16; ++c) { const float u = us[(sub * 16 + j) * 16 + c]; ur += u * bbr[c]; ui += u * bbi[c]; }
            bur[j] = ur; bui[j] = ui;
            const float nr_ = lbr * er - lbi * ei + ur, ni_ = lbr * ei + lbi * er + ui; er = nr_; ei = ni_; }
        E[(sub * 64 + p) * 2] = er; E[(sub * 64 + p) * 2 + 1] = ei;
        __syncthreads();
        float hr = 0.f, hi_ = 0.f;
        { float sr = cr, si = ci;
#pragma unroll
          for (int k = 0; k < 8; ++k) { if (k == sub) { hr = sr; hi_ = si; }
              const float e_r = E[(k * 64 + p) * 2], e_i = E[(k * 64 + p) * 2 + 1];
              const float nr_ = l16r * sr - l16i * si + e_r, ni_ = l16r * si + l16i * sr + e_i; sr = nr_; si = ni_; }
          cr = sr; ci = si; }
#pragma unroll
        for (int j = 0; j < 16; ++j) { const float nr_ = lbr * hr - lbi * hi_ + bur[j], ni_ = lbr * hi_ + lbi * hr + bui[j]; hr = nr_; hi_ = ni_;
            Hre[(sub * 16 + j) * 65 + p] = hr; Him[(sub * 16 + j) * 65 + p] = hi_; }
        __syncthreads();
        { float y[4] = {0.f, 0.f, 0.f, 0.f};
          for (int pp = 0; pp < 64; ++pp) { const float h_r = Hre[t_ld * 65 + pp], h_i = Him[t_ld * 65 + pp];
              const f32x4 c_r = *(const LAS f32x4*)(Cre + pp * 16 + c4), c_i = *(const LAS f32x4*)(Cim + pp * 16 + c4);
#pragma unroll
              for (int k = 0; k < 4; ++k) y[k] += c_r[k] * h_r - c_i[k] * h_i; }
#pragma unroll
          for (int k = 0; k < 4; ++k) y[k] = gelu_tanh(y[k] + Dsk[c4 + k] * us[t_ld * 16 + c4 + k]);
          u32x2 w; w.x = cvtpk(y[0], y[1]); w.y = cvtpk(y[2], y[3]);
          *(u32x2*)(Y + (size_t)(rowbase + seg * 128 + t_ld) * 512 + g * 16 + c4) = w; }
        __syncthreads();
    }
}

__device__ __forceinline__ void lru_unit(Frame& F, int b, int n) {
    const int tid = F.tid, c = tid & 63, sub = __builtin_amdgcn_readfirstlane(tid >> 6);
    LAS float* XC = (LAS float*)F.lds;
    LAS float* WA = XC + 8192;
    LAS float* WX = WA + 4096;
    LAS float* PE = WX + 4096;
    __syncthreads();
    for (int i = tid; i < 4096; i += NTHR) { WA[i] = INF(28)[n * 4096 + i]; WX[i] = INF(30)[n * 4096 + i]; }
    const int ch = n * 64 + c;
    float cw[4];
#pragma unroll
    for (int i = 0; i < 4; ++i) cw[i] = INF(26)[i * 512 + ch];
    const float cb = INF(27)[ch], ba = INF(29)[ch], bx = INF(31)[ch];
    const float lam = INF(32)[ch];
    const float ls = fminf(lam, 0.f) - log1pf(expf(-fabsf(lam)));
    const bf16_t* proj = (const bf16_t*)(F.ws + WS_PROJ1);
    bf16_t* mix = (bf16_t*)(F.ws + WS_MIX);
    const int rowbase = b * SEQ;
    float carry = 0.f;
    __syncthreads();
    for (int seg = 0; seg < SEQ / 128; ++seg) {
        const int T0 = seg * 128 + sub * 16;
        float xr[19];
#pragma unroll
        for (int k = 0; k < 19; ++k) { const int T = T0 - 3 + k; xr[k] = (T >= 0) ? bf2f(proj[(size_t)(rowbase + T) * IN1 + 1536 + ch]) : 0.f; }
        float xc[16];
#pragma unroll
        for (int j = 0; j < 16; ++j) { xc[j] = cb + cw[0] * xr[j] + cw[1] * xr[j + 1] + cw[2] * xr[j + 2] + cw[3] * xr[j + 3]; XC[(sub * 16 + j) * 64 + c] = xc[j]; }
        __syncthreads();
        float av[16], iv[16];
#pragma unroll
        for (int q4 = 0; q4 < 4; ++q4) {
            float ra[4] = {0.f, 0.f, 0.f, 0.f}, ia[4] = {0.f, 0.f, 0.f, 0.f};
            for (int cc = 0; cc < 64; ++cc) { const float wa = WA[cc * 64 + c], wx = WX[cc * 64 + c];
#pragma unroll
                for (int q = 0; q < 4; ++q) { const float x = XC[(sub * 16 + q4 * 4 + q) * 64 + cc]; ra[q] += x * wa; ia[q] += x * wx; } }
#pragma unroll
            for (int q = 0; q < 4; ++q) { const int j = q4 * 4 + q; const float r = sigmoidf_(ra[q] + ba), ig = sigmoidf_(ia[q] + bx);
                const float log_a = 8.0f * r * ls; av[j] = expf(log_a); iv[j] = sqrtf(-expm1f(2.0f * log_a)) * (ig * xc[j]); }
        }
        float P = 1.f, e = 0.f;
#pragma unroll
        for (int j = 0; j < 16; ++j) { e = av[j] * e + iv[j]; P *= av[j]; }
        PE[(sub * 64 + c) * 2] = P; PE[(sub * 64 + c) * 2 + 1] = e;
        __syncthreads();
        float h = 0.f;
        { float s = carry;
#pragma unroll
          for (int k = 0; k < 8; ++k) { if (k == sub) h = s; s = PE[(k * 64 + c) * 2] * s + PE[(k * 64 + c) * 2 + 1]; }
          carry = s; }
#pragma unroll
        for (int j = 0; j < 16; ++j) { h = av[j] * h + iv[j];
            const size_t row = (size_t)(rowbase + T0 + j);
            const float yg = bf2f(proj[row * IN1 + 2048 + ch]);
            const float o = h * gelu_tanh(yg);
            mix[row * D + 512 + ch] = (unsigned short)(cvtpk(o, o) & 0xffffu); }
        __syncthreads();
    }
}

enum { ST_PREP = 0, ST_XN0, ST_IN0, ST_R2, ST_S5, ST_QUP, ST_KVUP, ST_MLA, ST_GLU, ST_OUT0, ST_NORM0A, ST_GU0, ST_DN0, ST_NORM0B,
       ST_IN1, ST_SB, ST_LRU, ST_OUT1, ST_NORM1A, ST_GU1, ST_DN1, ST_NORM1B, ST_COUNT };
__host__ __device__ constexpr bool bar_after(int st) { return !(st == ST_S5 || st == ST_QUP || st == ST_MLA || st == ST_SB); }

template <int ST> __device__ __forceinline__ void run_step(Frame& F) {
    unsigned char* ws = F.ws;
    bool is_gemm = false; pg8::Gemm g{}; pg8::EpiP e{};
    if constexpr (ST == ST_PREP) step_prep(F);
    else if constexpr (ST == ST_XN0) step_xn0(F);
    else if constexpr (ST == ST_IN0) { g = {(const bf16_t*)(ws + WS_XN), (const bf16_t*)(ws + W_IN0), M, IN0P, 1024, 1024}; e.mode = pg8::EM_BF16; e.perm = 1; e.O = ws + WS_PROJ0; e.ldc = IN0P; is_gemm = true; }
    else if constexpr (ST == ST_R2) step_r2(F);
    else if constexpr (ST == ST_S5) { for (int u = F.bid; u < 256; u += F.G) s5_unit(F, u >> 5, u & 31); __syncthreads(); }
    else if constexpr (ST == ST_QUP) { g = {(const bf16_t*)(ws + WS_PROJ0), (const bf16_t*)(ws + W_QUP), M, 768, 384, IN0P}; e.mode = pg8::EM_BF16; e.perm = 1; e.O = ws + WS_Q; e.ldc = 768; e.rs = (const float*)(ws + WS_RS); is_gemm = true; }
    else if constexpr (ST == ST_KVUP) { g = {(const bf16_t*)(ws + WS_PROJ0) + 384, (const bf16_t*)(ws + W_KVUP), M, 1024, 256, IN0P}; e.mode = pg8::EM_KV; e.perm = 1; e.O = ws + WS_K96; e.O2 = ws + WS_V; e.rs = (const float*)(ws + WS_RS) + M; is_gemm = true; }
    else if constexpr (ST == ST_MLA) {
        for (int u = F.bid; u < 256; u += F.G) { const int bh = u >> 2, pr = u & 3, b = bh >> 3, h = bh & 7;
            for (int k = 0; k < 2; ++k) { const int qb = k ? 7 - pr : pr;
                attn_unit<96, 0>(F.lds, (const bf16_t*)(ws + WS_Q) + h * 96, 768, (const bf16_t*)(ws + WS_K96) + h * 96, 768, (const bf16_t*)(ws + WS_V) + h * 64, 512,
                                 (bf16_t*)(ws + WS_MIX) + h * 64, 1024, b, qb, (const int*)F.a->in[2], F.tid); } }
        __syncthreads(); }
    else if constexpr (ST == ST_GLU) { g = {(const bf16_t*)(ws + WS_Y), (const bf16_t*)(ws + W_GLU), M, 512, 512, 512}; e.mode = pg8::EM_GLU; e.perm = 1; e.O = ws + WS_MIX; e.ldc = 1024; e.bias = INF(24); e.Yin = (const bf16_t*)(ws + WS_Y); is_gemm = true; }
    else if constexpr (ST == ST_OUT0) { g = {(const bf16_t*)(ws + WS_MIX), (const bf16_t*)(ws + W_OUT0), M, 1024, 1024, 1024}; e.mode = pg8::EM_F32; e.perm = 0; e.O = ws + WS_FOUT; e.ldc = 1024; is_gemm = true; }
    else if constexpr (ST == ST_NORM0A) step_norm(F, (const float*)(ws + WS_FOUT), INF(0), INF(5) + 1 * D, 2048, 0, true, INF(5) + 2 * D, 0, 3072, 4096);
    else if constexpr (ST == ST_GU0) { g = {(const bf16_t*)(ws + WS_XN), (const bf16_t*)(ws + W_GU0), M, 2 * FFH, 1024, 1024}; e.mode = pg8::EM_SWIGLU; e.perm = 1; e.O = ws + WS_HID; e.ldc = FFH; is_gemm = true; }
    else if constexpr (ST == ST_DN0) { g = {(const bf16_t*)(ws + WS_HID), (const bf16_t*)(ws + W_DN0), M, 1024, FFH, FFH}; e.mode = pg8::EM_F32; e.perm = 0; e.O = ws + WS_FDN; e.ldc = 1024; is_gemm = true; }
    else if constexpr (ST == ST_NORM0B) step_norm(F, (const float*)(ws + WS_FDN), F.a->out, INF(5) + 3 * D, 5120, 0, true, INF(5) + 4 * D, 1, 0, 1024);
    else if constexpr (ST == ST_IN1) { g = {(const bf16_t*)(ws + WS_XN), (const bf16_t*)(ws + W_IN1), M, IN1, 1024, 1024}; e.mode = pg8::EM_BF16; e.perm = 1; e.O = ws + WS_PROJ1; e.ldc = IN1; is_gemm = true; }
    else if constexpr (ST == ST_SB) {
        for (int u = F.bid; u < 256; u += F.G) { const int bh = u >> 2, pr = u & 3, b = bh >> 3, h = bh & 7;
            for (int k = 0; k < 2; ++k) { const int qb = k ? 7 - pr : pr;
                attn_unit<64, 1>(F.lds, (const bf16_t*)(ws + WS_PROJ1) + h * 64, IN1, (const bf16_t*)(ws + WS_PROJ1) + 512 + h * 64, IN1, (const bf16_t*)(ws + WS_PROJ1) + 1024 + h * 64, IN1,
                                 (bf16_t*)(ws + WS_MIX) + h * 64, 1024, b, qb, (const int*)F.a->in[2], F.tid); } }
        __syncthreads(); }
    else if constexpr (ST == ST_LRU) { for (int u = F.bid; u < 64; u += F.G) lru_unit(F, u >> 3, u & 7); __syncthreads(); }
    else if constexpr (ST == ST_OUT1) { g = {(const bf16_t*)(ws + WS_MIX), (const bf16_t*)(ws + W_OUT1), M, 1024, 1024, 1024}; e.mode = pg8::EM_F32; e.perm = 0; e.O = ws + WS_FOUT; e.ldc = 1024; is_gemm = true; }
    else if constexpr (ST == ST_NORM1A) step_norm(F, (const float*)(ws + WS_FOUT), F.a->out, INF(5) + 5 * D, 2048, 1, true, INF(5) + 6 * D, 1, 3072, 4096);
    else if constexpr (ST == ST_GU1) { g = {(const bf16_t*)(ws + WS_XN), (const bf16_t*)(ws + W_GU1), M, 2 * FFH, 1024, 1024}; e.mode = pg8::EM_SWIGLU; e.perm = 1; e.O = ws + WS_HID; e.ldc = FFH; is_gemm = true; }
    else if constexpr (ST == ST_DN1) { g = {(const bf16_t*)(ws + WS_HID), (const bf16_t*)(ws + W_DN1), M, 1024, FFH, FFH}; e.mode = pg8::EM_F32; e.perm = 0; e.O = ws + WS_FDN; e.ldc = 1024; is_gemm = true; }
    else if constexpr (ST == ST_NORM1B) step_norm(F, (const float*)(ws + WS_FDN), F.a->out, INF(5) + 7 * D, 5120, 1, false, nullptr, 0, 0, 0);
    if (is_gemm) { pg8::StaticOrder S; S.init(g.M, g.N, F.G, F.bid); pg8::gemm_phase(F.lds, g, S, e); }
}

template <int ST, int HI> struct StepSeq {
    template <class BarT> static __device__ __forceinline__ void run(Frame& F, const BarT& bar) {
        run_step<ST>(F);
        if constexpr (ST + 1 < HI) {
#if MK_SINGLE
            if constexpr (bar_after(ST)) xcd_barrier(bar);
#endif
            StepSeq<ST + 1, HI>::run(F, bar);
        }
    }
};

template <int LO, int HI>
__global__ void __launch_bounds__(NTHR, 2) trunk_fwd(Args args) {
    extern __shared__ __attribute__((aligned(16))) unsigned char lds[];
    Frame F;
    F.lds = (LAS unsigned char*)lds; F.tid = threadIdx.x; F.lane = F.tid & 63; F.wave = __builtin_amdgcn_readfirstlane(F.tid >> 6);
    F.G = gridDim.x; F.bid = blockIdx.x; F.a = &args; F.ws = args.ws;
    volatile LAS unsigned* MISC = (volatile LAS unsigned*)(F.lds + MISC_OFF);
    for (int u = F.tid; u < (LDS_BYTES - LDSCTL_OFF) / 4; u += NTHR) ((LAS unsigned*)(F.lds + LDSCTL_OFF))[u] = 0u;
    __syncthreads();
#if MK_SINGLE
    XcdBarrier bar = xcd_barrier_post((unsigned*)(args.ws + WS_CTL) + 4096, MISC + 8);
#else
    int bar = 0; (void)MISC;
#endif
    StepSeq<LO, HI>::run(F, bar);
}

template <int LO, int HI> static void launch_range(int grid, const Args& a, hipStream_t stream) {
    static bool attr = false;
    if (!attr) { (void)hipFuncSetAttribute((const void*)trunk_fwd<LO, HI>, hipFuncAttributeMaxDynamicSharedMemorySize, LDS_BYTES); attr = true; }
    hipLaunchKernelGGL((trunk_fwd<LO, HI>), dim3(grid), dim3(NTHR), LDS_BYTES, stream, a);
}
extern "C" void kernel_launch(void* const* d_in, const int* in_sizes, int n_in, void* d_out, int out_size, void* d_ws, size_t ws_size, hipStream_t stream) {
    static int grid = 0;
    if (grid == 0) {
        if (n_in != 33 || out_size != M * D || ws_size < WS_END) { fprintf(stderr, "kernel_launch: unexpected shapes (n_in %d out %d ws %zu)\n", n_in, out_size, ws_size); grid = -1; return; }
        int dev = 0, cus = 0, per_cu = 0;
        if (hipGetDevice(&dev) != hipSuccess || hipDeviceGetAttribute(&cus, hipDeviceAttributeMultiprocessorCount, dev) != hipSuccess) { grid = -1; return; }
#if MK_SINGLE
        if (hipFuncSetAttribute((const void*)trunk_fwd<0, ST_COUNT>, hipFuncAttributeMaxDynamicSharedMemorySize, LDS_BYTES) != hipSuccess) { fprintf(stderr, "kernel_launch: hipFuncSetAttribute failed\n"); grid = -1; return; }
        if (hipOccupancyMaxActiveBlocksPerMultiprocessor(&per_cu, (const void*)trunk_fwd<0, ST_COUNT>, NTHR, LDS_BYTES) != hipSuccess || per_cu < 1) { fprintf(stderr, "kernel_launch: occupancy query says %d blocks/CU\n", per_cu); (void)hipGetLastError(); grid = -1; return; }
#else
        (void)per_cu;
#endif
        grid = cus;
    }
    if (grid < 0) return;
    (void)hipMemsetAsync((char*)d_ws + WS_CTL, 0, CTL_ZERO_BYTES, stream);
    Args a{};
    for (int i = 0; i < 33; ++i) a.in[i] = d_in[i];
    a.out = (float*)d_out; a.ws = (unsigned char*)d_ws;
#if MK_SINGLE
    launch_range<0, ST_COUNT>(grid, a, stream);
#else
    launch_range<ST_PREP, ST_PREP + 1>(grid, a, stream);
    launch_range<ST_XN0, ST_XN0 + 1>(grid, a, stream);
    launch_range<ST_IN0, ST_IN0 + 1>(grid, a, stream);
    launch_range<ST_R2, ST_R2 + 1>(grid, a, stream);
    launch_range<ST_S5, ST_S5 + 1>(grid, a, stream);
    launch_range<ST_QUP, ST_QUP + 1>(grid, a, stream);
    launch_range<ST_KVUP, ST_KVUP + 1>(grid, a, stream);
    launch_range<ST_MLA, ST_MLA + 1>(grid, a, stream);
    launch_range<ST_GLU, ST_GLU + 1>(grid, a, stream);
    launch_range<ST_OUT0, ST_OUT0 + 1>(grid, a, stream);
    launch_range<ST_NORM0A, ST_NORM0A + 1>(grid, a, stream);
    launch_range<ST_GU0, ST_GU0 + 1>(grid, a, stream);
    launch_range<ST_DN0, ST_DN0 + 1>(grid, a, stream);
    launch_range<ST_NORM0B, ST_NORM0B + 1>(grid, a, stream);
    launch_range<ST_IN1, ST_IN1 + 1>(grid, a, stream);
    launch_range<ST_SB, ST_SB + 1>(grid, a, stream);
    launch_range<ST_LRU, ST_LRU + 1>(grid, a, stream);
    launch_range<ST_OUT1, ST_OUT1 + 1>(grid, a, stream);
    launch_range<ST_NORM1A, ST_NORM1A + 1>(grid, a, stream);
    launch_range<ST_GU1, ST_GU1 + 1>(grid, a, stream);
    launch_range<ST_DN1, ST_DN1 + 1>(grid, a, stream);
    launch_range<ST_NORM1B, ST_NORM1B + 1>(grid, a, stream);
#endif
}
```
